# Optimizing an MI355X kernel written in HIP

```python
import math
import jax, jax.numpy as jnp
from jax import lax
import numpy as np

D_MODEL = 1024
BATCH = 16
SEQ = 2048
DEPTH = 1

MLA_HEADS = 8
MLA_Q_LORA = 256
MLA_KV_LORA = 256
MLA_NOPE = 64
MLA_ROPE = 32
MLA_V = 64
ROPE_THETA = 10000.0
Q_BLOCK = 128
SWA_HEADS = 8
SWA_KV_HEADS = 2
SWA_GROUP = SWA_HEADS // SWA_KV_HEADS
SWA_HEAD_DIM = 64
SWA_WINDOW = 128
N_EXPERTS = 256
TOP_K = 8
N_GROUPS = 8
TOPK_GROUPS = 4
EXPERT_HIDDEN = 256
SHARED_HIDDEN = 256
ROUTED_SCALE = 2.5
EXPERT_BLOCK = 128
DEEPNORM_ALPHA = (2.0 * DEPTH) ** 0.25
DEEPNORM_BETA = (8.0 * DEPTH) ** -0.25
LN_EPS = 1e-5
RMS_EPS = 1e-6

MLA_OUT = MLA_HEADS * MLA_V
SWA_OUT = SWA_HEADS * SWA_HEAD_DIM
IN_SPLIT_SIZES = [MLA_Q_LORA, MLA_KV_LORA, MLA_ROPE,
                  SWA_HEADS * SWA_HEAD_DIM, SWA_KV_HEADS * SWA_HEAD_DIM, SWA_KV_HEADS * SWA_HEAD_DIM,
                  D_MODEL, D_MODEL]
IN_PROJ_DIM = sum(IN_SPLIT_SIZES)
IN_SPLIT_POINTS = [int(v) for v in np.cumsum(IN_SPLIT_SIZES)[:-1]]

kernel_name = 'hybrid_mla_swa_gated_moe_deepnorm'


def layer_norm(x, g, b):
    xf = x.astype(jnp.float32)
    mu = jnp.mean(xf, axis=-1, keepdims=True)
    var = jnp.mean(jnp.square(xf - mu), axis=-1, keepdims=True)
    y = (xf - mu) * lax.rsqrt(var + LN_EPS)
    return (y * g.astype(jnp.float32) + b.astype(jnp.float32)).astype(x.dtype)


def rms_norm(x, g):
    xf = x.astype(jnp.float32)
    y = xf * lax.rsqrt(jnp.mean(jnp.square(xf), axis=-1, keepdims=True) + RMS_EPS)
    return (y * g.astype(jnp.float32)).astype(x.dtype)


def rope_tables(seq_len):
    inv_freq = ROPE_THETA ** (-jnp.arange(0, MLA_ROPE, 2, dtype=jnp.float32) / MLA_ROPE)
    ang = jnp.arange(seq_len, dtype=jnp.float32)[:, None] * inv_freq[None, :]
    return jnp.cos(ang), jnp.sin(ang)


def apply_rope(x, cos, sin):
    half = x.shape[-1] // 2
    x1, x2 = x[..., :half], x[..., half:]
    out = jnp.concatenate([x1 * cos - x2 * sin, x1 * sin + x2 * cos], axis=-1)
    return out.astype(x.dtype)


def alibi_slopes(n_heads):
    return 2.0 ** (-8.0 * jnp.arange(1, n_heads + 1, dtype=jnp.float32) / n_heads)


def mla_branch(c_q, c_kv, k_rope_raw, q_norm_g, kv_norm_g, w_uq, w_ukv):
    B, S, _ = c_q.shape
    q = (rms_norm(c_q, q_norm_g) @ w_uq).reshape(B, S, MLA_HEADS, MLA_NOPE + MLA_ROPE)
    q_nope, q_rope = q[..., :MLA_NOPE], q[..., MLA_NOPE:]
    kv = (rms_norm(c_kv, kv_norm_g) @ w_ukv).reshape(B, S, MLA_HEADS, MLA_NOPE + MLA_V)
    k_nope, v = kv[..., :MLA_NOPE], kv[..., MLA_NOPE:]
    cos, sin = rope_tables(S)
    q_rope = apply_rope(q_rope, cos[:, None, :], sin[:, None, :])
    k_rope = apply_rope(k_rope_raw, cos, sin)
    scale = 1.0 / math.sqrt(MLA_NOPE + MLA_ROPE)
    nb = S // Q_BLOCK
    qn_b = jnp.moveaxis(q_nope.reshape(B, nb, Q_BLOCK, MLA_HEADS, MLA_NOPE), 1, 0)
    qr_b = jnp.moveaxis(q_rope.reshape(B, nb, Q_BLOCK, MLA_HEADS, MLA_ROPE), 1, 0)
    key_pos = jnp.arange(S)

    def attend(args):
        qn, qr, blk = args
        s = (jnp.einsum('bqhd,bkhd->bhqk', qn, k_nope, preferred_element_type=jnp.float32)
             + jnp.einsum('bqhr,bkr->bhqk', qr, k_rope, preferred_element_type=jnp.float32)) * scale
        q_pos = blk * Q_BLOCK + jnp.arange(Q_BLOCK)
        s = jnp.where(key_pos[None, :] <= q_pos[:, None], s, -jnp.inf)
        p = jax.nn.softmax(s, axis=-1).astype(v.dtype)
        return jnp.einsum('bhqk,bkhd->bqhd', p, v)

    out = lax.map(attend, (qn_b, qr_b, jnp.arange(nb)))
    return jnp.moveaxis(out, 0, 1).reshape(B, S, MLA_OUT)


def swa_branch(q, k, v, attn_sinks):
    B, S, _ = q.shape
    W = SWA_WINDOW
    nb = S // W
    q = q.reshape(B, nb, W, SWA_KV_HEADS, SWA_GROUP, SWA_HEAD_DIM)
    k = k.reshape(B, S, SWA_KV_HEADS, SWA_HEAD_DIM)
    v = v.reshape(B, S, SWA_KV_HEADS, SWA_HEAD_DIM)

    def band(t):
        pad = jnp.zeros((B, W) + t.shape[2:], t.dtype)
        prev = jnp.concatenate([pad, t[:, :S - W]], axis=1).reshape(B, nb, W, SWA_KV_HEADS, SWA_HEAD_DIM)
        cur = t.reshape(B, nb, W, SWA_KV_HEADS, SWA_HEAD_DIM)
        return jnp.concatenate([prev, cur], axis=2)

    k_band, v_band = band(k), band(v)
    scale = 1.0 / math.sqrt(SWA_HEAD_DIM)
    s = jnp.einsum('bnikgd,bnjkd->bnkgij', q, k_band, preferred_element_type=jnp.float32) * scale
    i = jnp.arange(W)[:, None]
    j = jnp.arange(2 * W)[None, :]
    dist = i + W - j
    key_pos = jnp.arange(nb)[:, None] * W + jnp.arange(2 * W)[None, :] - W
    valid = ((dist >= 0) & (dist < W))[None, :, :] & (key_pos >= 0)[:, None, :]
    slopes = alibi_slopes(SWA_HEADS).reshape(SWA_KV_HEADS, SWA_GROUP)[:, :, None, None]
    s = s - slopes * dist.astype(jnp.float32)
    s = jnp.where(valid[None, :, None, None], s, -jnp.inf)
    sink = attn_sinks.astype(jnp.float32).reshape(SWA_KV_HEADS, SWA_GROUP)[:, :, None, None]
    m = jnp.maximum(jnp.max(s, axis=-1, keepdims=True), sink)
    p = jnp.exp(s - m)
    denom = jnp.sum(p, axis=-1, keepdims=True) + jnp.exp(sink - m)
    p = (p / denom).astype(v.dtype)
    out = jnp.einsum('bnkgij,bnjkd->bnikgd', p, v_band)
    return out.reshape(B, S, SWA_OUT)


def token_mixer(x, w_in, mla_q_norm, mla_kv_norm, w_uq, w_ukv, attn_sinks, w_o_mla, w_o_swa, w_out):
    proj = x @ w_in
    c_q, c_kv, k_rope, q_s, k_s, v_s, gate_a, gate_b = jnp.split(proj, IN_SPLIT_POINTS, axis=-1)
    y_a = mla_branch(c_q, c_kv, k_rope, mla_q_norm, mla_kv_norm, w_uq, w_ukv) @ w_o_mla
    y_b = swa_branch(q_s, k_s, v_s, attn_sinks) @ w_o_swa
    merged = jax.nn.sigmoid(gate_a) * y_a + jax.nn.sigmoid(gate_b) * y_b
    return merged @ w_out


def route(h, w_router, router_bias):
    T = h.shape[0]
    scores = jax.nn.sigmoid((h @ w_router).astype(jnp.float32))
    choice = scores + router_bias.astype(jnp.float32)
    grp = choice.reshape(T, N_GROUPS, N_EXPERTS // N_GROUPS)
    grp_score = jnp.sum(lax.top_k(grp, 2)[0], axis=-1)
    _, grp_idx = lax.top_k(grp_score, TOPK_GROUPS)
    grp_mask = jnp.any(grp_idx[:, :, None] == jnp.arange(N_GROUPS)[None, None, :], axis=1)
    expert_mask = jnp.repeat(grp_mask, N_EXPERTS // N_GROUPS, axis=1)
    _, top_idx = lax.top_k(jnp.where(expert_mask, choice, -jnp.inf), TOP_K)
    w = jnp.take_along_axis(scores, top_idx, axis=-1)
    w = w / jnp.sum(w, axis=-1, keepdims=True) * ROUTED_SCALE
    return top_idx, w


def routed_experts(h, top_idx, top_w, w_exp_up, w_exp_down):
    T = h.shape[0]
    TK = T * TOP_K
    e_flat = top_idx.reshape(-1).astype(jnp.int32)
    tok_flat = jnp.repeat(jnp.arange(T, dtype=jnp.int32), TOP_K)
    w_flat = top_w.reshape(-1).astype(h.dtype)
    order = jnp.argsort(e_flat)
    sorted_e = e_flat[order]
    sizes = jax.ops.segment_sum(jnp.ones((TK,), jnp.int32), e_flat, num_segments=N_EXPERTS)
    start = jnp.cumsum(sizes) - sizes
    pad_sizes = (sizes + EXPERT_BLOCK - 1) // EXPERT_BLOCK * EXPERT_BLOCK
    pad_end = jnp.cumsum(pad_sizes)
    pad_start = pad_end - pad_sizes
    dest = pad_start[sorted_e] + (jnp.arange(TK, dtype=jnp.int32) - start[sorted_e])
    n_rows = (TK + EXPERT_BLOCK - 1) // EXPERT_BLOCK * EXPERT_BLOCK + N_EXPERTS * EXPERT_BLOCK
    n_blocks = n_rows // EXPERT_BLOCK
    row_tok = jnp.zeros((n_rows,), jnp.int32).at[dest].set(tok_flat[order])
    row_w = jnp.zeros((n_rows,), h.dtype).at[dest].set(w_flat[order])
    blk_start = jnp.arange(n_blocks, dtype=jnp.int32) * EXPERT_BLOCK
    blk_expert = jnp.clip(jnp.searchsorted(pad_end, blk_start, side='right'), 0, N_EXPERTS - 1)

    def step(acc, blk):
        tok, wt, e = blk
        xb = h[tok]
        gu = xb @ w_exp_up[e]
        hid = jax.nn.silu(gu[:, :EXPERT_HIDDEN]) * gu[:, EXPERT_HIDDEN:]
        yb = (hid @ w_exp_down[e]) * wt[:, None]
        return acc.at[tok].add(yb), None

    acc, _ = lax.scan(step, jnp.zeros_like(h),
                      (row_tok.reshape(n_blocks, EXPERT_BLOCK), row_w.reshape(n_blocks, EXPERT_BLOCK), blk_expert))
    return acc


def moe_ffn(x, w_router, router_bias, w_exp_up, w_exp_down, w_sh_up, w_sh_down):
    B, S, D = x.shape
    h = x.reshape(B * S, D)
    top_idx, top_w = route(h, w_router, router_bias)
    routed = routed_experts(h, top_idx, top_w, w_exp_up, w_exp_down)
    gu = h @ w_sh_up
    shared = (jax.nn.silu(gu[:, :SHARED_HIDDEN]) * gu[:, SHARED_HIDDEN:]) @ w_sh_down
    return (routed + shared).reshape(B, S, D)


def setup_inputs(seed: int = 0) -> dict:
    key = jax.random.key(seed)
    ks = jax.random.split(key, 20)
    f32 = jnp.float32

    def nrm(k, shape, scale):
        return jax.random.normal(k, shape, f32) * scale

    return {
        'x': nrm(ks[0], (BATCH, SEQ, D_MODEL), 1.0),
        'w_in': nrm(ks[1], (D_MODEL, IN_PROJ_DIM), D_MODEL ** -0.5),
        'mla_q_norm': 1.0 + nrm(ks[2], (MLA_Q_LORA,), 0.02),
        'mla_kv_norm': 1.0 + nrm(ks[3], (MLA_KV_LORA,), 0.02),
        'w_uq': nrm(ks[4], (MLA_Q_LORA, MLA_HEADS * (MLA_NOPE + MLA_ROPE)), MLA_Q_LORA ** -0.5),
        'w_ukv': nrm(ks[5], (MLA_KV_LORA, MLA_HEADS * (MLA_NOPE + MLA_V)), MLA_KV_LORA ** -0.5),
        'attn_sinks': nrm(ks[6], (SWA_HEADS,), 0.5),
        'w_o_mla': nrm(ks[7], (MLA_OUT, D_MODEL), DEEPNORM_BETA * MLA_OUT ** -0.5),
        'w_o_swa': nrm(ks[8], (SWA_OUT, D_MODEL), DEEPNORM_BETA * SWA_OUT ** -0.5),
        'w_out': nrm(ks[9], (D_MODEL, D_MODEL), DEEPNORM_BETA * D_MODEL ** -0.5),
        'ln1_g': 1.0 + nrm(ks[10], (D_MODEL,), 0.02),
        'ln1_b': nrm(ks[11], (D_MODEL,), 0.02),
        'w_router': nrm(ks[12], (D_MODEL, N_EXPERTS), D_MODEL ** -0.5),
        'router_bias': nrm(ks[13], (N_EXPERTS,), 0.01),
        'w_exp_up': nrm(ks[14], (N_EXPERTS, D_MODEL, 2 * EXPERT_HIDDEN), D_MODEL ** -0.5),
        'w_exp_down': nrm(ks[15], (N_EXPERTS, EXPERT_HIDDEN, D_MODEL), DEEPNORM_BETA * EXPERT_HIDDEN ** -0.5),
        'w_sh_up': nrm(ks[16], (D_MODEL, 2 * SHARED_HIDDEN), D_MODEL ** -0.5),
        'w_sh_down': nrm(ks[17], (SHARED_HIDDEN, D_MODEL), DEEPNORM_BETA * SHARED_HIDDEN ** -0.5),
        'ln2_g': 1.0 + nrm(ks[18], (D_MODEL,), 0.02),
        'ln2_b': nrm(ks[19], (D_MODEL,), 0.02),
    }


def reference(x, w_in, mla_q_norm, mla_kv_norm, w_uq, w_ukv, attn_sinks, w_o_mla, w_o_swa, w_out,
              ln1_g, ln1_b, w_router, router_bias, w_exp_up, w_exp_down, w_sh_up, w_sh_down,
              ln2_g, ln2_b):
    h = x
    for _ in range(DEPTH):
        mix = token_mixer(h, w_in, mla_q_norm, mla_kv_norm, w_uq, w_ukv, attn_sinks, w_o_mla, w_o_swa, w_out)
        h = layer_norm(DEEPNORM_ALPHA * h + mix, ln1_g, ln1_b)
        ffn = moe_ffn(h, w_router, router_bias, w_exp_up, w_exp_down, w_sh_up, w_sh_down)
        h = layer_norm(DEEPNORM_ALPHA * h + ffn, ln2_g, ln2_b)
    return h
```

```cpp
#include <hip/hip_runtime.h>
#include <cstdio>
#include <cstdint>

#ifndef MK_N_LAUNCHES
#define MK_N_LAUNCHES 1
#endif

#define LAS __attribute__((address_space(3)))
#define GAS __attribute__((address_space(1)))
typedef unsigned short bf16_t;
typedef short bf16x8 __attribute__((ext_vector_type(8)));
typedef short s16x4 __attribute__((ext_vector_type(4)));
typedef float f32x4 __attribute__((ext_vector_type(4)));
typedef float f32x2 __attribute__((ext_vector_type(2)));
typedef float f32x16 __attribute__((ext_vector_type(16)));
typedef unsigned u32x4 __attribute__((ext_vector_type(4)));
typedef unsigned u32x2 __attribute__((ext_vector_type(2)));
typedef __bf16 bf16x2_t __attribute__((ext_vector_type(2)));

constexpr int TT = 32768, DM = 1024, SEQ = 2048, NB = 16;
constexpr int NIN = 3584;
constexpr int NEXP = 256, NE1 = 257;
constexpr int MAXROWS = 360704;
constexpr float ALPHA = 1.189207115002721f;
constexpr float LOG2E = 1.4426950408889634f;
constexpr float C2M = 0.10206207261596575f * LOG2E;
constexpr float QSC = 0.125f * LOG2E;
constexpr float LN_EPS = 1e-5f, RMS_EPS = 1e-6f;

constexpr size_t MiB = 1u << 20;
constexpr size_t WS_CTL = 0, CTL_ZERO_BYTES = 1 * MiB;
constexpr size_t WS_ROPE = 1 * MiB;
constexpr size_t WS_WIN = 2 * MiB, WS_WUQ = 9 * MiB, WS_WUKV = 10 * MiB, WS_WOM = 11 * MiB, WS_WOS = 12 * MiB, WS_WOUT = 13 * MiB, WS_WR = 15 * MiB;
constexpr size_t WS_WUP = 16 * MiB, WS_WDN = 273 * MiB;
constexpr size_t WS_TOPI = 403 * MiB, WS_TOPW = 404 * MiB, WS_TPOS = 405 * MiB, WS_RTOK = 406 * MiB, WS_RSLOT = 408 * MiB, WS_RW = 410 * MiB;
constexpr size_t WS_SSQ = 402 * MiB;
constexpr size_t WS_SC = 412 * MiB, WS_H1F = 444 * MiB, WS_H1B = 572 * MiB, WS_HID = 636 * MiB;
constexpr size_t WS_R = 813 * MiB;
constexpr size_t WS_XB = WS_R, WS_CQ = WS_R + 64 * MiB, WS_CKV = WS_R + 80 * MiB, WS_QS = WS_R + 96 * MiB, WS_KS = WS_R + 128 * MiB, WS_VS = WS_R + 136 * MiB,
                 WS_GA = WS_R + 144 * MiB, WS_GB = WS_R + 208 * MiB, WS_QF = WS_R + 272 * MiB, WS_KF = WS_R + 320 * MiB, WS_VM = WS_R + 368 * MiB,
                 WS_AM = WS_R + 400 * MiB, WS_AS = WS_R + 432 * MiB, WS_MG = WS_R + 464 * MiB, WS_Y1 = WS_R + 528 * MiB;
constexpr size_t WS_Y = WS_R;
constexpr size_t WS_END = WS_R + 656 * MiB;
constexpr int CW_BAR = 4096;
constexpr int CW_CNT = 16384;

constexpr int RING_OFF = 0, RING_BYTES = 131072;
constexpr int LDSCTL_OFF = RING_BYTES, MISC_OFF = LDSCTL_OFF + 320;
constexpr int TILEOFF_OFF = 131584;
constexpr int ROWTAB_OFF = 133120, ROWTAB_UNITS = 24;
constexpr int LDS_BYTES = 163840;
static_assert(ROWTAB_OFF + ROWTAB_UNITS * 1024 <= LDS_BYTES, "lds");

#define RLX_AGENT __ATOMIC_RELAXED, __HIP_MEMORY_SCOPE_AGENT
#define LDS_WAIT() asm volatile("s_waitcnt lgkmcnt(0)" ::: "memory")
#define VM_WAIT() asm volatile("s_waitcnt vmcnt(0)" ::: "memory")

__device__ __forceinline__ unsigned cvtpk(float lo, float hi) { f32x2 v = {lo, hi}; bf16x2_t b = __builtin_convertvector(v, bf16x2_t); return __builtin_bit_cast(unsigned, b); }
__device__ __forceinline__ float bf2f(unsigned short h) { return __builtin_bit_cast(float, (unsigned)h << 16); }
__device__ __forceinline__ float bflo(unsigned w) { return __builtin_bit_cast(float, w << 16); }
__device__ __forceinline__ float bfhi(unsigned w) { return __builtin_bit_cast(float, w & 0xffff0000u); }
__device__ __forceinline__ float sigmoidf_(float v) { return __builtin_amdgcn_rcpf(1.0f + __builtin_amdgcn_exp2f(-v * LOG2E)); }

namespace pg8 {
constexpr int BM = 256, BK = 64, HALF = 128, HTB = HALF * BK * 2, STAGE_BYTES = 8 * HTB, NXCD = 8, WGM = 8;
__host__ __device__ __forceinline__ int lds_byte(int r, int c) { const int st = (r >> 4) * 2 + (c >> 5), rr = r & 15, cc = c & 31, ob = rr * 64 + cc * 2; return st * 1024 + (ob ^ (((ob >> 9) & 1) << 5)); }
__host__ __device__ __forceinline__ void stage_rc(int b, int& R, int& C) { const int st = b / 1024, sb = b % 1024, swz = sb ^ (((sb >> 9) & 1) << 5); R = (st >> 1) * 16 + swz / 64; C = (st & 1) * 32 + (swz % 64) / 2; }
__host__ __device__ __forceinline__ int perm32(int rho) { const int n = rho >> 4, i = rho & 15; return 8 * (i >> 2) + 4 * n + (i & 3); }

struct Unit { int pm, pn; };

__device__ __forceinline__ int xcd_remap(int L, int nwg) { const int q = nwg / NXCD, r = nwg % NXCD, xcd = L % NXCD, off = L / NXCD; return (xcd < r ? xcd * (q + 1) : r * (q + 1) + (xcd - r) * q) + off; }

struct StaticOrder {
    int nM, nN, nwg, G, c;
    __device__ void init(int M, int N, int G_, int c_) { nM = M / BM; nN = N / BM; nwg = nM * nN; G = G_; c = c_; }
    __device__ bool next(int i, Unit& u) const {
        const long L = (long)i * G + c; if (L >= nwg) return false;
        const int wgid = xcd_remap((int)L, nwg);
        const int nig = WGM * nN, gid = wgid / nig, fm = gid * WGM, gsz = (nM - fm) < WGM ? (nM - fm) : WGM;
        u.pm = fm + ((wgid % nig) % gsz); u.pn = (wgid % nig) / gsz; return true;
    }
};
struct GroupOrder {
    int ntiles, nN, nwg, G, c; const LAS int* tileoff;
    __device__ void init(int ntiles_, int nN_, int G_, int c_, const LAS int* to) { ntiles = ntiles_; nN = nN_; nwg = ntiles * nN; G = G_; c = c_; tileoff = to; }
    __device__ bool next(int i, Unit& u) const {
        const long L = (long)i * G + c; if (L >= nwg) return false;
        const int wgid = xcd_remap((int)L, nwg);
        const int tau = wgid / nN, pn = wgid % nN;
        int lo = 0, hi = NE1;
        while (hi - lo > 1) { const int mid = (lo + hi) >> 1; if (tileoff[mid] <= tau) lo = mid; else hi = mid; }
        u.pm = tau; u.pn = lo * nN + pn; return true;
    }
};

template <class Epi, class Sched, bool ALIGN_EPI, bool GATHER>
__device__ __forceinline__ void gemm_phase(LAS unsigned char* lds, const bf16_t* Abase, const bf16_t* Btbase, const int K, const Sched& S, const Epi& E, const LAS int* rowtab) {
    const int tid = threadIdx.x, wid = __builtin_amdgcn_readfirstlane(tid >> 6), lane = tid & 63, wr = wid >> 2, wc = wid & 3, fr = lane & 15, fq = lane >> 4;
    const int nt = K / BK;
    unsigned voffB[2];
#pragma unroll
    for (int i = 0; i < 2; ++i) { int R, C; stage_rc(tid * 16 + i * 8192, R, C); const int Rb = Epi::PERM ? ((R & ~31) + perm32(R & 31)) : R; voffB[i] = (unsigned)(Rb * K + C) * 2u; }
    const size_t kstep = (size_t)(BK * 2);
    const size_t hstep = (size_t)HALF * K * 2;
    const size_t tstep = 2 * hstep;
    const unsigned ldsw = (unsigned)wid * 1024u;
    const int aoff = lds_byte(wr * 64 + fr, fq * 8), boff = lds_byte(wc * 32 + fr, fq * 8);
    const char* Ab = (const char*)Abase;
#define PG8_SA(b, h) (((b) * 2 + (h)) * HTB)
#define PG8_SB(b, h) ((4 + (b) * 2 + (h)) * HTB)
#define PG8_STAGE(bufoff, gbase, voff) do { _Pragma("unroll") for (int _i = 0; _i < 2; ++_i) \
        __builtin_amdgcn_global_load_lds((const unsigned*)((const char*)(gbase) + (voff)[_i]), (LAS unsigned*)(lds + (bufoff) + ldsw + _i * 8192), 16, 0, 0); } while (0)
#define PG8_LDA(dst, b, h) do { _Pragma("unroll") for (int m = 0; m < 4; ++m) _Pragma("unroll") for (int k = 0; k < 2; ++k) dst[m][k] = *(const LAS bf16x8*)(lds + PG8_SA(b, h) + aoff + m * 2048 + k * 1024); } while (0)
#define PG8_LDB(dst, b, h) do { _Pragma("unroll") for (int n = 0; n < 2; ++n) _Pragma("unroll") for (int k = 0; k < 2; ++k) dst[n][k] = *(const LAS bf16x8*)(lds + PG8_SB(b, h) + boff + n * 2048 + k * 1024); } while (0)
#define PG8_MMA(ai, bj, At, Bt) do { __builtin_amdgcn_s_setprio(1); _Pragma("unroll") for (int m = 0; m < 4; ++m) _Pragma("unroll") for (int n = 0; n < 2; ++n) _Pragma("unroll") for (int k = 0; k < 2; ++k) \
        acc[ai][bj][m][n] = __builtin_amdgcn_mfma_f32_16x16x32_bf16(Bt[n][k], At[m][k], acc[ai][bj][m][n], 0, 0, 0); __builtin_amdgcn_s_setprio(0); } while (0)
#define PG8_WAIT_V(n) asm volatile("s_waitcnt vmcnt(" #n ")" ::: "memory")
#define PG8_WAIT_L(n) asm volatile("s_waitcnt lgkmcnt(" #n ")" ::: "memory")
#define PG8_BAR __builtin_amdgcn_s_barrier()
#define PG8_SCHED __builtin_amdgcn_sched_barrier(0)
#define PG8_MKVA(va, u, ui_) do { _Pragma("unroll") for (int _h = 0; _h < 2; ++_h) _Pragma("unroll") for (int _i = 0; _i < 2; ++_i) { int _R, _C; stage_rc(tid * 16 + _i * 8192, _R, _C); \
        const int _row = GATHER ? rowtab[(ui_) * 256 + _h * 128 + _R] : ((u).pm * 256 + _h * 128 + _R); (va)[_h][_i] = (unsigned)(_row * K + _C) * 2u; } } while (0)
    Unit cur, nxt; int ui = 0;
    if (!S.next(0, cur)) return;
    f32x4 acc[2][2][4][2];
#pragma unroll
    for (int a = 0; a < 2; ++a)
#pragma unroll
        for (int b = 0; b < 2; ++b)
#pragma unroll
            for (int m = 0; m < 4; ++m)
#pragma unroll
                for (int n = 0; n < 2; ++n) acc[a][b][m][n] = (f32x4){0.f, 0.f, 0.f, 0.f};
    bf16x8 At[4][2], B0[2][2], B1[2][2];
    unsigned vaC[2][2];
    PG8_MKVA(vaC, cur, 0);
    const char* cB = (const char*)Btbase + (size_t)cur.pn * tstep;
    PG8_STAGE(PG8_SB(0, 0), cB, voffB); PG8_STAGE(PG8_SB(0, 1), cB + hstep, voffB); PG8_STAGE(PG8_SA(0, 0), Ab, vaC[0]); PG8_STAGE(PG8_SA(0, 1), Ab, vaC[1]);
    if (wr == 1) PG8_BAR;
    PG8_WAIT_V(2); PG8_BAR;
    PG8_STAGE(PG8_SB(1, 0), cB + kstep, voffB); PG8_STAGE(PG8_SA(1, 0), Ab + kstep, vaC[0]); PG8_STAGE(PG8_SB(1, 1), cB + hstep + kstep, voffB);
    PG8_WAIT_V(6); PG8_BAR;
    for (;;) {
        const bool has_next = S.next(ui + 1, nxt);
        const char* nB = has_next ? (const char*)Btbase + (size_t)nxt.pn * tstep : cB;
#pragma unroll 1
        for (int t = 0; t < nt; t += 2) {
            const bool last = (t == nt - 2);
            const char* a1 = Ab + (size_t)(t + 1) * kstep;
            const char* a2 = last ? Ab : Ab + (size_t)(t + 2) * kstep; const char* b2 = last ? nB : cB + (size_t)(t + 2) * kstep;
            const char* a3 = a2 + kstep; const char* b3 = b2 + kstep;
            unsigned vx[2][2];
            if (last && has_next) { PG8_MKVA(vx, nxt, ui + 1); } else {
#pragma unroll
                for (int h = 0; h < 2; ++h)
#pragma unroll
                    for (int i = 0; i < 2; ++i) vx[h][i] = vaC[h][i]; }
            PG8_LDB(B0, 0, 0); PG8_LDB(B1, 0, 1); PG8_SCHED; PG8_LDA(At, 0, 0); PG8_STAGE(PG8_SA(1, 1), a1, vaC[1]);
            PG8_WAIT_V(8); PG8_WAIT_L(0); PG8_BAR; PG8_MMA(0, 0, At, B0); PG8_MMA(0, 1, At, B1); PG8_BAR; PG8_SCHED;
            PG8_LDA(At, 0, 1); PG8_STAGE(PG8_SB(0, 0), b2, voffB); PG8_STAGE(PG8_SB(0, 1), b2 + hstep, voffB); PG8_STAGE(PG8_SA(0, 0), a2, vx[0]);
            PG8_WAIT_V(8); PG8_WAIT_L(0); PG8_BAR; PG8_MMA(1, 0, At, B0); PG8_MMA(1, 1, At, B1); PG8_BAR; PG8_SCHED;
            PG8_LDB(B0, 1, 0); PG8_LDB(B1, 1, 1); PG8_SCHED; PG8_LDA(At, 1, 0); PG8_STAGE(PG8_SA(0, 1), a2, vx[1]);
            PG8_WAIT_V(8); PG8_WAIT_L(0); PG8_BAR; PG8_MMA(0, 0, At, B0); PG8_MMA(0, 1, At, B1); PG8_BAR; PG8_SCHED;
            PG8_LDA(At, 1, 1); PG8_STAGE(PG8_SB(1, 0), b3, voffB); PG8_STAGE(PG8_SB(1, 1), b3 + hstep, voffB); PG8_STAGE(PG8_SA(1, 0), a3, vx[0]);
            PG8_WAIT_V(8); PG8_WAIT_L(0); PG8_BAR; PG8_MMA(1, 0, At, B0); PG8_MMA(1, 1, At, B1); PG8_BAR; PG8_SCHED;
        }
        if constexpr (ALIGN_EPI) { if (wr == 0) PG8_BAR; }
        E(acc, cur, wr, wc, fr, fq);
        if (!has_next) break;
#pragma unroll
        for (int a = 0; a < 2; ++a)
#pragma unroll
            for (int b = 0; b < 2; ++b)
#pragma unroll
                for (int m = 0; m < 4; ++m)
#pragma unroll
                    for (int n = 0; n < 2; ++n) acc[a][b][m][n] = (f32x4){0.f, 0.f, 0.f, 0.f};
        cur = nxt; cB = nB; ++ui;
        PG8_MKVA(vaC, cur, ui);
        if constexpr (ALIGN_EPI) { if (wr == 1) PG8_BAR; }
    }
    PG8_WAIT_V(0);
    if constexpr (!ALIGN_EPI) { if (wr == 0) PG8_BAR; }
    PG8_BAR;
#undef PG8_SA
#undef PG8_SB
#undef PG8_STAGE
#undef PG8_LDA
#undef PG8_LDB
#undef PG8_MMA
#undef PG8_WAIT_V
#undef PG8_WAIT_L
#undef PG8_BAR
#undef PG8_SCHED
#undef PG8_MKVA
}
}

typedef f32x4 AccT[2][2][4][2];
#define EPI_LOOP_ROWS for (int ai = 0; ai < 2; ++ai) _Pragma("unroll") for (int m = 0; m < 4; ++m)
__device__ __forceinline__ u32x4 pack8(const f32x4 a, const f32x4 b) { u32x4 w; w.x = cvtpk(a[0], a[1]); w.y = cvtpk(a[2], a[3]); w.z = cvtpk(b[0], b[1]); w.w = cvtpk(b[2], b[3]); return w; }

struct EpiInProj {
    static constexpr bool PERM = true;
    bf16_t *CQ, *CKV, *QS, *KS, *VS, *KF, *GA, *GB; float *SSQQ, *SSQKV; const float* ROPE;
    __device__ __forceinline__ void operator()(const AccT& acc, const pg8::Unit& u, int wr, int wc, int fr, int fq) const {
        const int pn = u.pn, row0 = u.pm * 256 + wr * 64 + fr, cl = wc * 32 + 8 * fq;
        if (pn <= 1) {
            bf16_t* O = pn == 0 ? CQ : CKV; float* ssq = pn == 0 ? SSQQ : SSQKV;
#pragma unroll
            EPI_LOOP_ROWS { const int row = row0 + ai * 128 + m * 16; float s = 0.f;
#pragma unroll
                for (int bj = 0; bj < 2; ++bj) { const f32x4 v0 = acc[ai][bj][m][0], v1 = acc[ai][bj][m][1];
                    s += (v0[0] * v0[0] + v0[1] * v0[1]) + (v0[2] * v0[2] + v0[3] * v0[3]) + (v1[0] * v1[0] + v1[1] * v1[1]) + (v1[2] * v1[2] + v1[3] * v1[3]);
                    *(u32x4*)(O + (size_t)row * 256 + bj * 128 + cl) = pack8(v0, v1); }
                s += __shfl_xor(s, 16); s += __shfl_xor(s, 32);
                if (fq == 0) ssq[row * 4 + wc] = s; }
        } else if (pn <= 3) {
#pragma unroll
            EPI_LOOP_ROWS { const int row = row0 + ai * 128 + m * 16;
#pragma unroll
                for (int bj = 0; bj < 2; ++bj) *(u32x4*)(QS + (size_t)row * 512 + (pn - 2) * 256 + bj * 128 + cl) = pack8(acc[ai][bj][m][0] * QSC, acc[ai][bj][m][1] * QSC); }
        } else if (pn == 4) {
#pragma unroll
            EPI_LOOP_ROWS { const int row = row0 + ai * 128 + m * 16;
                *(u32x4*)(KS + (size_t)row * 128 + cl) = pack8(acc[ai][0][m][0], acc[ai][0][m][1]);
                *(u32x4*)(VS + (size_t)row * 128 + cl) = pack8(acc[ai][1][m][0], acc[ai][1][m][1]); }
        } else if (pn == 5) {
            if (wc == 0) {
#pragma unroll
                EPI_LOOP_ROWS { const int row = row0 + ai * 128 + m * 16; const int pos = row & (SEQ - 1);
                    const f32x4 c = *(const f32x4*)(ROPE + pos * 16 + 4 * fq), s = *(const f32x4*)(ROPE + SEQ * 16 + pos * 16 + 4 * fq);
                    const f32x4 x1 = acc[ai][0][m][0], x2 = acc[ai][0][m][1];
                    const u32x4 w = pack8(x1 * c - x2 * s, x1 * s + x2 * c);
#pragma unroll
                    for (int h = 0; h < 8; ++h) *(u32x4*)(KF + (size_t)row * 768 + h * 96 + 64 + 8 * fq) = w; }
            }
        } else {
            bf16_t* O = pn <= 9 ? GA + (pn - 6) * 256 : GB + (pn - 10) * 256;
#pragma unroll
            EPI_LOOP_ROWS { const int row = row0 + ai * 128 + m * 16;
#pragma unroll
                for (int bj = 0; bj < 2; ++bj) { f32x4 v0 = acc[ai][bj][m][0], v1 = acc[ai][bj][m][1];
#pragma unroll
                    for (int j = 0; j < 4; ++j) { v0[j] = sigmoidf_(v0[j]); v1[j] = sigmoidf_(v1[j]); }
                    *(u32x4*)(O + (size_t)row * 1024 + bj * 128 + cl) = pack8(v0, v1); } }
        }
    }
};
struct EpiQ {
    static constexpr bool PERM = true;
    bf16_t* QF; const float* SSQQ; const float* ROPE;
    __device__ __forceinline__ void operator()(const AccT& acc, const pg8::Unit& u, int wr, int wc, int fr, int fq) const {
        const int row0 = u.pm * 256 + wr * 64 + fr, cl = wc * 32 + 8 * fq;
#pragma unroll
        EPI_LOOP_ROWS { const int row = row0 + ai * 128 + m * 16; const int pos = row & (SEQ - 1);
            const f32x4 sq = *(const f32x4*)(SSQQ + row * 4); const float rs = __builtin_amdgcn_rsqf(((sq[0] + sq[1]) + (sq[2] + sq[3])) * (1.0f / 256.0f) + RMS_EPS) * C2M;
#pragma unroll
            for (int bj = 0; bj < 2; ++bj) { const int g32 = u.pn * 8 + bj * 4 + wc;
                f32x4 v0 = acc[ai][bj][m][0] * rs, v1 = acc[ai][bj][m][1] * rs;
                if (g32 % 3 == 2) { const f32x4 c = *(const f32x4*)(ROPE + pos * 16 + 4 * fq), s = *(const f32x4*)(ROPE + SEQ * 16 + pos * 16 + 4 * fq);
                    const f32x4 a = v0 * c - v1 * s, b = v0 * s + v1 * c; v0 = a; v1 = b; }
                *(u32x4*)(QF + (size_t)row * 768 + u.pn * 256 + bj * 128 + cl) = pack8(v0, v1); } }
    }
};
struct EpiKV {
    static constexpr bool PERM = true;
    bf16_t *KF, *VM; const float* SSQKV;
    __device__ __forceinline__ void operator()(const AccT& acc, const pg8::Unit& u, int wr, int wc, int fr, int fq) const {
        const int row0 = u.pm * 256 + wr * 64 + fr;
#pragma unroll
        EPI_LOOP_ROWS { const int row = row0 + ai * 128 + m * 16;
            const f32x4 sq = *(const f32x4*)(SSQKV + row * 4); const float rs = __builtin_amdgcn_rsqf(((sq[0] + sq[1]) + (sq[2] + sq[3])) * (1.0f / 256.0f) + RMS_EPS);
#pragma unroll
            for (int bj = 0; bj < 2; ++bj) { const int h = u.pn * 2 + bj; const u32x4 w = pack8(acc[ai][bj][m][0] * rs, acc[ai][bj][m][1] * rs);
                if (wc < 2) *(u32x4*)(KF + (size_t)row * 768 + h * 96 + wc * 32 + 8 * fq) = w;
                else        *(u32x4*)(VM + (size_t)row * 512 + h * 64 + (wc - 2) * 32 + 8 * fq) = w; } }
    }
};
template <bool SECOND> struct EpiGate {
    static constexpr bool PERM = true;
    bf16_t* MG; const bf16_t* G;
    __device__ __forceinline__ void operator()(const AccT& acc, const pg8::Unit& u, int wr, int wc, int fr, int fq) const {
        const int row0 = u.pm * 256 + wr * 64 + fr, col0 = u.pn * 256 + wc * 32 + 8 * fq;
#pragma unroll
        EPI_LOOP_ROWS { const int row = row0 + ai * 128 + m * 16;
#pragma unroll
            for (int bj = 0; bj < 2; ++bj) { const size_t off = (size_t)row * 1024 + col0 + bj * 128;
                const u32x4 g = *(const u32x4*)(G + off);
                f32x4 v0 = acc[ai][bj][m][0], v1 = acc[ai][bj][m][1];
                v0[0] *= bflo(g.x); v0[1] *= bfhi(g.x); v0[2] *= bflo(g.y); v0[3] *= bfhi(g.y); v1[0] *= bflo(g.z); v1[1] *= bfhi(g.z); v1[2] *= bflo(g.w); v1[3] *= bfhi(g.w);
                if (SECOND) { const u32x4 p = *(const u32x4*)(MG + off);
                    v0[0] += bflo(p.x); v0[1] += bfhi(p.x); v0[2] += bflo(p.y); v0[3] += bfhi(p.y); v1[0] += bflo(p.z); v1[1] += bfhi(p.z); v1[2] += bflo(p.w); v1[3] += bfhi(p.w); }
                *(u32x4*)(MG + off) = pack8(v0, v1); } }
    }
};
struct EpiOut {
    static constexpr bool PERM = false;
    float* Y1; const float* X;
    __device__ __forceinline__ void operator()(const AccT& acc, const pg8::Unit& u, int wr, int wc, int fr, int fq) const {
        const int row0 = u.pm * 256 + wr * 64 + fr, col0 = u.pn * 256 + wc * 32 + 4 * fq;
#pragma unroll
        EPI_LOOP_ROWS { const size_t ro = (size_t)(row0 + ai * 128 + m * 16) * 1024 + col0;
#pragma unroll
            for (int bj = 0; bj < 2; ++bj)
#pragma unroll
                for (int n = 0; n < 2; ++n) { const size_t off = ro + bj * 128 + n * 16; const f32x4 xv = *(const f32x4*)(X + off); *(f32x4*)(Y1 + off) = xv * ALPHA + acc[ai][bj][m][n]; } }
    }
};
struct EpiRouter {
    static constexpr bool PERM = false;
    float* SC;
    __device__ __forceinline__ void operator()(const AccT& acc, const pg8::Unit& u, int wr, int wc, int fr, int fq) const {
        const int row0 = u.pm * 256 + wr * 64 + fr, col0 = wc * 32 + 4 * fq;
#pragma unroll
        EPI_LOOP_ROWS { const size_t ro = (size_t)(row0 + ai * 128 + m * 16) * 256 + col0;
#pragma unroll
            for (int bj = 0; bj < 2; ++bj)
#pragma unroll
                for (int n = 0; n < 2; ++n) { f32x4 v = acc[ai][bj][m][n];
#pragma unroll
                    for (int j = 0; j < 4; ++j) v[j] = sigmoidf_(v[j]);
                    *(f32x4*)(SC + ro + bj * 128 + n * 16) = v; } }
    }
};
struct EpiUp {
    static constexpr bool PERM = true;
    bf16_t* HID;
    __device__ __forceinline__ void operator()(const AccT& acc, const pg8::Unit& u, int wr, int wc, int fr, int fq) const {
        const int row0 = u.pm * 256 + wr * 64 + fr, col0 = (u.pn & 1) * 128 + wc * 32 + 8 * fq;
#pragma unroll
        EPI_LOOP_ROWS { const int row = row0 + ai * 128 + m * 16; f32x4 h0, h1;
#pragma unroll
            for (int j = 0; j < 4; ++j) { const float g0 = acc[ai][0][m][0][j], g1 = acc[ai][0][m][1][j];
                h0[j] = g0 * sigmoidf_(g0) * acc[ai][1][m][0][j]; h1[j] = g1 * sigmoidf_(g1) * acc[ai][1][m][1][j]; }
            *(u32x4*)(HID + (size_t)row * 256 + col0) = pack8(h0, h1); }
    }
};
struct EpiDown {
    static constexpr bool PERM = true;
    bf16_t* Y; const int* RSLOT; const float* RW;
    __device__ __forceinline__ void operator()(const AccT& acc, const pg8::Unit& u, int wr, int wc, int fr, int fq) const {
        const int row0 = u.pm * 256 + wr * 64 + fr, col0 = (u.pn & 3) * 256 + wc * 32 + 8 * fq;
#pragma unroll
        EPI_LOOP_ROWS { const int row = row0 + ai * 128 + m * 16; const int slot = RSLOT[row]; const float w = RW[row];
            if (slot >= 0) {
#pragma unroll
                for (int bj = 0; bj < 2; ++bj) *(u32x4*)(Y + (size_t)slot * 1024 + col0 + bj * 128) = pack8(acc[ai][bj][m][0] * w, acc[ai][bj][m][1] * w); } }
    }
};

__device__ __forceinline__ s16x4 vtr(const LAS unsigned char* p) { return __builtin_bit_cast(s16x4, __builtin_amdgcn_ds_read_tr16_b64_v4i16((LAS s16x4*)p)); }
template <int DQK, bool SWA>
__device__ __forceinline__ void attn_unit(LAS unsigned char* lds, const bf16_t* Qh, int qp, const bf16_t* Kh, int kp, const bf16_t* Vh, int vp, bf16_t* Oh, int op,
                                          int pos0, int t_lo, int t_hi, float slope2, float sink2) {
    constexpr int NCH = DQK / 8, NDK = DQK / 16, KBY = NCH * 1024;
    constexpr int OFF_K = 0, OFF_V = 2 * KBY, OFF_SCR = 2 * KBY + 16384, OFF_OST = OFF_SCR + 2048;
    const int tid = threadIdx.x, lane = tid & 63, r32 = lane & 31, hi = lane >> 5; const int wid = __builtin_amdgcn_readfirstlane(tid >> 6);
    const int qmin = pos0 + wid * 32, qpos = qmin + r32, qmax = qmin + 31;
    bf16x8 qr[NDK];
    { const bf16_t* qrow = Qh + (size_t)qpos * qp;
#pragma unroll
      for (int d0 = 0; d0 < NDK; ++d0) qr[d0] = *(const bf16x8*)(qrow + d0 * 16 + hi * 8); }
    float m_run = -INFINITY, l_run = 0.f; f32x16 o0 = {}, o1 = {};
    LAS float* scr = (LAS float*)(lds + OFF_SCR) + wid * 64;
#define ATT_STAGE(t_, b_) do { \
        for (int c_ = wid; c_ < NCH; c_ += 8) __builtin_amdgcn_global_load_lds((const unsigned*)(Kh + (size_t)((t_) * 64 + lane) * kp + c_ * 8), (LAS unsigned*)(lds + OFF_K + (b_) * KBY + c_ * 1024), 16, 0, 0); \
        __builtin_amdgcn_global_load_lds((const unsigned*)(Vh + (size_t)((t_) * 64 + 16 * (wid & 3) + (lane >> 2)) * vp + (wid >> 2) * 32 + (lane & 3) * 8), (LAS unsigned*)(lds + OFF_V + (b_) * 8192 + wid * 1024), 16, 0, 0); } while (0)
    ATT_STAGE(t_lo, 0);
    for (int t = t_lo; t < t_hi; ++t) {
        const int buf = (t - t_lo) & 1;
        VM_WAIT(); __syncthreads();
        if (t + 1 < t_hi) ATT_STAGE(t + 1, buf ^ 1);
        const int kmin = t * 64, kmax = kmin + 63;
        const bool need = SWA ? (kmax >= qmin - 127 && kmin <= qmax) : (kmin <= qmax);
        if (need) {
            f32x16 p0 = {}, p1 = {};
            const LAS unsigned char* kb = lds + OFF_K + buf * KBY + hi * 1024 + r32 * 16;
#pragma unroll
            for (int d0 = 0; d0 < NDK; ++d0) { const bf16x8 b0 = *(const LAS bf16x8*)(kb + d0 * 2048), b1 = *(const LAS bf16x8*)(kb + d0 * 2048 + 512);
                p0 = __builtin_amdgcn_mfma_f32_32x32x16_bf16(b0, qr[d0], p0, 0, 0, 0); p1 = __builtin_amdgcn_mfma_f32_32x32x16_bf16(b1, qr[d0], p1, 0, 0, 0); }
            if (SWA) {
                const int dq = qpos - kmin - 4 * hi;
#pragma unroll
                for (int r = 0; r < 16; ++r) { const int d0_ = dq - ((r & 3) + 8 * (r >> 2)), d1_ = d0_ - 32;
                    p0[r] = (d0_ >= 0 && d0_ < 128) ? p0[r] - slope2 * (float)d0_ : -INFINITY;
                    p1[r] = (d1_ >= 0 && d1_ < 128) ? p1[r] - slope2 * (float)d1_ : -INFINITY; }
            } else if (kmax > qmin) {
                const int dq = qpos - kmin - 4 * hi;
#pragma unroll
                for (int r = 0; r < 16; ++r) { const int d0_ = dq - ((r & 3) + 8 * (r >> 2));
                    if (d0_ < 0) p0[r] = -INFINITY; if (d0_ < 32) p1[r] = -INFINITY; }
            }
            float rm = fmaxf(p0[0], p1[0]);
#pragma unroll
            for (int r = 1; r < 16; ++r) rm = fmaxf(rm, fmaxf(p0[r], p1[r]));
            rm = fmaxf(rm, __shfl_xor(rm, 32));
            const float mnew = fmaxf(m_run, rm), muse = (mnew == -INFINITY) ? 0.f : mnew;
            const float alpha = __builtin_amdgcn_exp2f(m_run - muse);
            float ls = 0.f;
#pragma unroll
            for (int r = 0; r < 16; ++r) { p0[r] = __builtin_amdgcn_exp2f(p0[r] - muse); p1[r] = __builtin_amdgcn_exp2f(p1[r] - muse); ls += p0[r] + p1[r]; }
            l_run = l_run * alpha + ls; m_run = mnew;
            if (!__all(alpha == 1.0f)) {
                if (hi == 0) scr[r32] = alpha;
                LDS_WAIT();
#pragma unroll
                for (int i = 0; i < 4; ++i) { const f32x4 a = *(const LAS f32x4*)(scr + 8 * i + 4 * hi);
#pragma unroll
                    for (int j = 0; j < 4; ++j) { o0[4 * i + j] *= a[j]; o1[4 * i + j] *= a[j]; } }
                LDS_WAIT();
            }
            u32x4 pw[4];
#pragma unroll
            for (int j = 0; j < 4; ++j) { pw[0][j] = cvtpk(p0[2 * j], p0[2 * j + 1]); pw[1][j] = cvtpk(p0[8 + 2 * j], p0[9 + 2 * j]); pw[2][j] = cvtpk(p1[2 * j], p1[2 * j + 1]); pw[3][j] = cvtpk(p1[8 + 2 * j], p1[9 + 2 * j]); }
            const LAS unsigned char* vb = lds + OFF_V + buf * 8192 + ((lane >> 4) & 1) * 32 + (lane & 3) * 8 + (4 * hi + ((lane & 15) >> 2)) * 64;
#pragma unroll
            for (int ks = 0; ks < 4; ++ks) {
                const s16x4 l0 = vtr(vb + ks * 1024), h0 = vtr(vb + ks * 1024 + 512), l1 = vtr(vb + 4096 + ks * 1024), h1 = vtr(vb + 4096 + ks * 1024 + 512);
                const bf16x8 v0 = (bf16x8){l0[0], l0[1], l0[2], l0[3], h0[0], h0[1], h0[2], h0[3]}, v1 = (bf16x8){l1[0], l1[1], l1[2], l1[3], h1[0], h1[1], h1[2], h1[3]};
                const bf16x8 pa = __builtin_bit_cast(bf16x8, pw[ks]);
                o0 = __builtin_amdgcn_mfma_f32_32x32x16_bf16(pa, v0, o0, 0, 0, 0); o1 = __builtin_amdgcn_mfma_f32_32x32x16_bf16(pa, v1, o1, 0, 0, 0); }
        }
    }
#undef ATT_STAGE
    float lt = l_run + __shfl_xor(l_run, 32), sc;
    if (SWA) { const float m2 = fmaxf(m_run, sink2), f = __builtin_amdgcn_exp2f(m_run - m2); sc = f / (lt * f + __builtin_amdgcn_exp2f(sink2 - m2)); }
    else sc = 1.0f / lt;
    if (hi == 0) scr[r32] = sc;
    LDS_WAIT();
    LAS bf16_t* stg = (LAS bf16_t*)(lds + OFF_OST) + wid * 2048;
#pragma unroll
    for (int i = 0; i < 4; ++i) { const f32x4 a = *(const LAS f32x4*)(scr + 8 * i + 4 * hi);
#pragma unroll
        for (int j = 0; j < 4; ++j) { const int orow = 8 * i + 4 * hi + j; const int r = 4 * i + j;
            stg[orow * 64 + r32] = (bf16_t)(cvtpk(o0[r] * a[j], 0.f) & 0xffffu); stg[orow * 64 + 32 + r32] = (bf16_t)(cvtpk(o1[r] * a[j], 0.f) & 0xffffu); } }
    LDS_WAIT();
#pragma unroll
    for (int i = 0; i < 4; ++i) { const int row = i * 8 + (lane >> 3), ch = lane & 7; const u32x4 v = *(const LAS u32x4*)(stg + row * 64 + ch * 8);
        *(u32x4*)(Oh + (size_t)(qmin + row) * op + ch * 8) = v; }
    LDS_WAIT(); __syncthreads();
}

#define XB_TMO      128
#define XB_XCNT(j)  (256  + 64 * (j))
#define XB_XSUB(j)  (1280 + 64 * (j))
#define XB_XGEN(j)  (2304 + 64 * (j))
#define XB_TOP      3328
#define XB_TOPGEN   3392
#define XCD_BAR_WORDS 3456
#define XB_SPIN_CAP (1u << 18)
__device__ __forceinline__ unsigned xb_ld(unsigned* p)              { return __hip_atomic_load(p, __ATOMIC_RELAXED, __HIP_MEMORY_SCOPE_AGENT); }
__device__ __forceinline__ unsigned xb_add(unsigned* p, unsigned v) { return __hip_atomic_fetch_add(p, v, __ATOMIC_RELAXED, __HIP_MEMORY_SCOPE_AGENT); }
__device__ __forceinline__ unsigned xb_xcc_id() { return (unsigned)__builtin_amdgcn_s_getreg((3 << 11) | 20) & 0xFu; }
#define XB_SPIN(cond, bar) do { unsigned _sp = 0; while (cond) { __builtin_amdgcn_s_sleep(1); \
    if ((++_sp & 255u) == 0u) { if (xb_ld(&(bar)[XB_TMO])) break; if (_sp > XB_SPIN_CAP) { atomicAdd(&(bar)[XB_TMO], 1u); break; } } } } while (0)
struct XcdBarrier { unsigned* bar; unsigned x; volatile LAS unsigned* st; };
__device__ __forceinline__ XcdBarrier xcd_barrier_post(unsigned* bar, volatile LAS unsigned* st) {
    XcdBarrier b; b.bar = bar; b.x = xb_xcc_id(); b.st = st;
    if (threadIdx.x == 0) (void)xb_add(&bar[XB_XCNT(b.x)], 1u);
    return b;
}
__device__ __forceinline__ void xcd_barrier_complete(unsigned* bar, unsigned x, unsigned& nloc, unsigned& nx) {
    const unsigned G = gridDim.x * gridDim.y * gridDim.z;
    unsigned sum, cnt, mine, sp = 0u;
    for (;;) {
        sum = 0u; cnt = 0u; mine = 0u;
#pragma unroll
        for (unsigned j = 0; j < 16; ++j) { const unsigned c = xb_ld(&bar[XB_XCNT(j)]); sum += c; cnt += (c > 0u) ? 1u : 0u; mine = (j == x) ? c : mine; }
        if (sum == G) break;
        __builtin_amdgcn_s_sleep(1);
        if ((++sp & 255u) == 0u) { if (xb_ld(&bar[XB_TMO])) break; if (sp > XB_SPIN_CAP) { atomicAdd(&bar[XB_TMO], 1u); break; } }
    }
    nloc = mine > 0u ? mine : 1u; nx = cnt > 0u ? cnt : 1u;
}
__device__ __forceinline__ void xcd_barrier(const XcdBarrier& b) {
    asm volatile("s_waitcnt vmcnt(0)" ::: "memory");
    __syncthreads();
    if (threadIdx.x == 0) {
        unsigned* bar = b.bar;
        __builtin_amdgcn_s_waitcnt(0);
        unsigned nloc = b.st[0], nx = b.st[1];
        if (nloc == 0u) { xcd_barrier_complete(bar, b.x, nloc, nx); b.st[0] = nloc; b.st[1] = nx; }
        const unsigned old = xb_add(&bar[XB_XSUB(b.x)], 1u);
        const unsigned gen = old / nloc;
        if (old + 1u == (gen + 1u) * nloc) {
            __builtin_amdgcn_fence(__ATOMIC_RELEASE, "agent");
            asm volatile("s_waitcnt vmcnt(0)" ::: "memory");
            const unsigned og = xb_add(&bar[XB_TOP], 1u);
            const unsigned tg = og / nx;
            if (og + 1u == (tg + 1u) * nx) xb_add(&bar[XB_TOPGEN], 1u);
            else XB_SPIN(xb_ld(&bar[XB_TOPGEN]) == tg, bar);
            __builtin_amdgcn_fence(__ATOMIC_ACQUIRE, "agent");
            xb_add(&bar[XB_XGEN(b.x)], 1u);
            asm volatile("s_waitcnt vmcnt(0)" ::: "memory");
        } else {
            XB_SPIN(xb_ld(&bar[XB_XGEN(b.x)]) == gen, bar);
            __builtin_amdgcn_fence(__ATOMIC_ACQUIRE, "agent");
            asm volatile("s_waitcnt vmcnt(0)" ::: "memory");
        }
    }
    __syncthreads();
}

__device__ __forceinline__ float wave_sum(float v) {
#pragma unroll
    for (int o = 1; o < 64; o <<= 1) v += __shfl_xor(v, o);
    return v;
}
__device__ __forceinline__ int rope_perm(int p) { return ((p >> 2) & 1) * 16 + 4 * (p >> 3) + (p & 3); }
__device__ __forceinline__ void transpose_block(const float* src, int ld, bf16_t* dst, int Kp, const float* scale, bool rperm, LAS float* scr, int lane) {
    f32x4 r[8];
#pragma unroll
    for (int i = 0; i < 8; ++i) r[i] = *(const f32x4*)(src + (size_t)(8 * i + (lane >> 3)) * ld + (lane & 7) * 4);
#pragma unroll
    for (int i = 0; i < 8; ++i) { const int kk = 8 * i + (lane >> 3); const float sc = scale ? scale[kk] : 1.0f; LAS float* s = scr + kk * 33 + (lane & 7) * 4;
        s[0] = r[i][0] * sc; s[1] = r[i][1] * sc; s[2] = r[i][2] * sc; s[3] = r[i][3] * sc; }
    LDS_WAIT(); asm volatile("" ::: "memory");
    const int c = lane & 7;
#pragma unroll
    for (int j = 0; j < 4; ++j) { const int n = (lane >> 3) + 8 * j; const int ns = rperm ? rope_perm(n) : n; const LAS float* s = scr + (8 * c) * 33 + ns;
        u32x4 o; o.x = cvtpk(s[0 * 33], s[1 * 33]); o.y = cvtpk(s[2 * 33], s[3 * 33]); o.z = cvtpk(s[4 * 33], s[5 * 33]); o.w = cvtpk(s[6 * 33], s[7 * 33]);
        *(u32x4*)(dst + (size_t)n * Kp + 8 * c) = o; }
    LDS_WAIT(); asm volatile("" ::: "memory");
}

struct Args { const float* in[20]; float* out; unsigned char* ws; int ph_lo, ph_hi; };

__device__ __forceinline__ void compute_tileoff(LAS unsigned char* lds, const unsigned* cnt, int tid) {
    LAS int* tl = (LAS int*)(lds + RING_OFF);
    LAS int* to = (LAS int*)(lds + TILEOFF_OFF);
    __syncthreads();
    if (tid < NE1) { const int c = (tid < NEXP) ? (int)__hip_atomic_load(cnt + tid, RLX_AGENT) : TT; tl[tid] = (c + 255) >> 8; }
    __syncthreads();
    if (tid <= NE1) { int s = 0; for (int e = 0; e < tid; ++e) s += tl[e]; to[tid] = s; }
    __syncthreads();
}

__global__ void __launch_bounds__(512, 2) mk_fwd(Args args) {
    extern __shared__ __attribute__((aligned(16))) unsigned char lds_raw[];
    LAS unsigned char* lds = (LAS unsigned char*)lds_raw;
    volatile LAS unsigned* MISC = (volatile LAS unsigned*)(lds + MISC_OFF);
    const int tid = threadIdx.x, lane = tid & 63, wave = __builtin_amdgcn_readfirstlane(tid >> 6);
    const int G = gridDim.x; const int bx = blockIdx.x; const int vcu = (G % 8 == 0) ? (bx % 8) * (G / 8) + bx / 8 : bx;
    unsigned char* ws = args.ws;
    unsigned* ctl = (unsigned*)(ws + WS_CTL);
    const float* x = args.in[0];
#define ROPE ((float*)(ws + WS_ROPE))
#define WinT ((bf16_t*)(ws + WS_WIN))
#define WuqT ((bf16_t*)(ws + WS_WUQ))
#define WukvT ((bf16_t*)(ws + WS_WUKV))
#define WomT ((bf16_t*)(ws + WS_WOM))
#define WosT ((bf16_t*)(ws + WS_WOS))
#define WoutT ((bf16_t*)(ws + WS_WOUT))
#define WrT ((bf16_t*)(ws + WS_WR))
#define WupT ((bf16_t*)(ws + WS_WUP))
#define WdnT ((bf16_t*)(ws + WS_WDN))
#define XB ((bf16_t*)(ws + WS_XB))
#define CQ ((bf16_t*)(ws + WS_CQ))
#define CKV ((bf16_t*)(ws + WS_CKV))
#define QS ((bf16_t*)(ws + WS_QS))
#define KS ((bf16_t*)(ws + WS_KS))
#define VS ((bf16_t*)(ws + WS_VS))
#define GA ((bf16_t*)(ws + WS_GA))
#define GB ((bf16_t*)(ws + WS_GB))
#define QF ((bf16_t*)(ws + WS_QF))
#define KF ((bf16_t*)(ws + WS_KF))
#define VM ((bf16_t*)(ws + WS_VM))
#define AM ((bf16_t*)(ws + WS_AM))
#define AS ((bf16_t*)(ws + WS_AS))
#define MG ((bf16_t*)(ws + WS_MG))
#define H1B ((bf16_t*)(ws + WS_H1B))
#define HID ((bf16_t*)(ws + WS_HID))
#define YS ((bf16_t*)(ws + WS_Y))
#define Y1 ((float*)(ws + WS_Y1))
#define H1F ((float*)(ws + WS_H1F))
#define SC ((float*)(ws + WS_SC))
#define TOPW ((float*)(ws + WS_TOPW))
#define RW ((float*)(ws + WS_RW))
#define TOPI ((int*)(ws + WS_TOPI))
#define TPOS ((int*)(ws + WS_TPOS))
#define RTOK ((int*)(ws + WS_RTOK))
#define RSLOT ((int*)(ws + WS_RSLOT))
#define SSQQ ((float*)(ws + WS_SSQ))
#define SSQKV ((float*)(ws + WS_SSQ) + TT * 4)
#define CNT (ctl + CW_CNT)

    for (int u = tid; u < (LDS_BYTES - LDSCTL_OFF) / 4; u += 512) ((LAS unsigned*)(lds + LDSCTL_OFF))[u] = 0u;
    __syncthreads();
    XcdBarrier bar; bar.bar = ctl + CW_BAR; bar.x = 0; bar.st = nullptr;
    if (MK_N_LAUNCHES == 1) bar = xcd_barrier_post(ctl + CW_BAR, MISC + 8);
    const int lo = args.ph_lo, hi = args.ph_hi;
#define IN(k) (lo <= (k) && (k) < hi)
#define SEAM(k) do { if (IN(k) && IN((k) + 1)) xcd_barrier(bar); } while (0)
    const int gw = vcu * 8 + wave, NGW = G * 8;

    if (IN(0)) {
        LAS float* scr = (LAS float*)(lds + RING_OFF + wave * 16384);
        constexpr int I_IN = 16 * 105, I_UQ = 4 * 24, I_UKV = 4 * 32, I_OM = 8 * 32, I_OS = 8 * 32, I_OUT = 16 * 32, I_R = 16 * 8, I_UP = NE1 * 256, I_DN = NE1 * 128;
        constexpr int NITEMS = I_IN + I_UQ + I_UKV + I_OM + I_OS + I_OUT + I_R + I_UP + I_DN;
        for (int it = gw; it < NITEMS; it += NGW) {
            int r = it;
            if (r < I_IN) { const int kb = r / 105, sb = r % 105; int db;
                if (sb < 16) db = sb; else if (sb == 16) db = 40; else if (sb < 33) db = sb - 1; else if (sb < 41) db = sb - 1; else db = sb + 7;
                transpose_block(args.in[1] + (size_t)kb * 64 * 3360 + sb * 32, 3360, WinT + (size_t)db * 32 * 1024 + kb * 64, 1024, nullptr, sb == 16, scr, lane); continue; } r -= I_IN;
            if (r < I_UQ) { const int kb = r / 24, nb = r % 24;
                transpose_block(args.in[4] + (size_t)kb * 64 * 768 + nb * 32, 768, WuqT + (size_t)nb * 32 * 256 + kb * 64, 256, args.in[2] + kb * 64, nb % 3 == 2, scr, lane); continue; } r -= I_UQ;
            if (r < I_UKV) { const int kb = r / 32, nb = r % 32;
                transpose_block(args.in[5] + (size_t)kb * 64 * 1024 + nb * 32, 1024, WukvT + (size_t)nb * 32 * 256 + kb * 64, 256, args.in[3] + kb * 64, false, scr, lane); continue; } r -= I_UKV;
            if (r < I_OM) { const int kb = r / 32, nb = r % 32;
                transpose_block(args.in[7] + (size_t)kb * 64 * 1024 + nb * 32, 1024, WomT + (size_t)nb * 32 * 512 + kb * 64, 512, nullptr, false, scr, lane); continue; } r -= I_OM;
            if (r < I_OS) { const int kb = r / 32, nb = r % 32;
                transpose_block(args.in[8] + (size_t)kb * 64 * 1024 + nb * 32, 1024, WosT + (size_t)nb * 32 * 512 + kb * 64, 512, nullptr, false, scr, lane); continue; } r -= I_OS;
            if (r < I_OUT) { const int kb = r / 32, nb = r % 32;
                transpose_block(args.in[9] + (size_t)kb * 64 * 1024 + nb * 32, 1024, WoutT + (size_t)nb * 32 * 1024 + kb * 64, 1024, nullptr, false, scr, lane); continue; } r -= I_OUT;
            if (r < I_R) { const int kb = r / 8, nb = r % 8;
                transpose_block(args.in[12] + (size_t)kb * 64 * 256 + nb * 32, 256, WrT + (size_t)nb * 32 * 1024 + kb * 64, 1024, nullptr, false, scr, lane); continue; } r -= I_R;
            if (r < I_UP) { const int e = r / 256, q = r % 256, kb = q / 16, sb = q % 16;
                const float* W = (e < NEXP) ? args.in[14] + (size_t)e * 1024 * 512 : args.in[16];
                const int db = (sb < 8) ? (sb >> 2) * 8 + (sb & 3) : ((sb - 8) >> 2) * 8 + 4 + ((sb - 8) & 3);
                transpose_block(W + (size_t)kb * 64 * 512 + sb * 32, 512, WupT + (size_t)e * 512 * 1024 + (size_t)db * 32 * 1024 + kb * 64, 1024, nullptr, false, scr, lane); continue; } r -= I_UP;
            { const int e = r / 128, q = r % 128, kb = q / 32, nb = q % 32;
                const float* W = (e < NEXP) ? args.in[15] + (size_t)e * 256 * 1024 : args.in[17];
                transpose_block(W + (size_t)kb * 64 * 1024 + nb * 32, 1024, WdnT + (size_t)e * 1024 * 256 + (size_t)nb * 32 * 256 + kb * 64, 256, nullptr, false, scr, lane); }
        }
        for (size_t i = (size_t)(bx * 512 + tid); i < (size_t)224 * 1024 / 8; i += (size_t)G * 512) *(u32x4*)(WinT + (size_t)1312 * 1024 + i * 8) = (u32x4){0u, 0u, 0u, 0u};
        for (int m = gw; m < TT; m += NGW) { const f32x4* xr = (const f32x4*)(x + (size_t)m * DM) + lane; u32x2* o = (u32x2*)(XB + (size_t)m * DM) + lane;
#pragma unroll
            for (int j = 0; j < 4; ++j) { const f32x4 v = xr[64 * j]; u32x2 w; w.x = cvtpk(v[0], v[1]); w.y = cvtpk(v[2], v[3]); o[64 * j] = w; } }
        for (int i = bx * 512 + tid; i < SEQ * 16; i += G * 512) { const int pos = i >> 4, j = i & 15; const float inv = powf(10000.0f, -(float)(2 * j) / 32.0f); const float ang = (float)pos * inv;
            ROPE[i] = cosf(ang); ROPE[SEQ * 16 + i] = sinf(ang); }
    }
    SEAM(0);
    if (IN(1)) {
        pg8::StaticOrder S; S.init(TT, NIN, G, bx);
        EpiInProj E{CQ, CKV, QS, KS, VS, KF, GA, GB, SSQQ, SSQKV, ROPE};
        pg8::gemm_phase<EpiInProj, pg8::StaticOrder, true, false>(lds + RING_OFF, XB, WinT, 1024, S, E, nullptr);
    }
    SEAM(1);
    if (IN(2)) {
        { pg8::StaticOrder S; S.init(TT, 768, G, bx); EpiQ E{QF, SSQQ, ROPE};
          pg8::gemm_phase<EpiQ, pg8::StaticOrder, true, false>(lds + RING_OFF, CQ, WuqT, 256, S, E, nullptr); }
        { pg8::StaticOrder S; S.init(TT, 1024, G, bx); EpiKV E{KF, VM, SSQKV};
          pg8::gemm_phase<EpiKV, pg8::StaticOrder, true, false>(lds + RING_OFF, CKV, WukvT, 256, S, E, nullptr); }
    }
    SEAM(2);
    if (IN(3)) {
        for (int P = vcu; P < 512; P += G) { const int bh = P >> 2, s = P & 3, b = bh >> 3, h = bh & 7; const size_t rb = (size_t)b * SEQ;
#pragma unroll 1
            for (int z = 0; z < 2; ++z) { const int qb = z ? 7 - s : s;
                attn_unit<96, false>(lds + RING_OFF, QF + rb * 768 + h * 96, 768, KF + rb * 768 + h * 96, 768, VM + rb * 512 + h * 64, 512, AM + rb * 512 + h * 64, 512, qb * 256, 0, 4 * (qb + 1), 0.f, 0.f); } }
        const float* sinks = args.in[6];
#pragma unroll 1
        for (int U = vcu; U < 1024; U += G) { const int bh = U >> 3, qb = U & 7, b = bh >> 3, h = bh & 7, kvh = h >> 2; const size_t rb = (size_t)b * SEQ;
            const float slope2 = exp2f(-(float)(h + 1)) * LOG2E, sink2 = sinks[h] * LOG2E;
            attn_unit<64, true>(lds + RING_OFF, QS + rb * 512 + h * 64, 512, KS + rb * 128 + kvh * 64, 128, VS + rb * 128 + kvh * 64, 128, AS + rb * 512 + h * 64, 512, qb * 256, (4 * qb - 2) < 0 ? 0 : 4 * qb - 2, 4 * qb + 4, slope2, sink2); }
    }
    SEAM(3);
    if (IN(4)) {
        { pg8::StaticOrder S; S.init(TT, 1024, G, bx); EpiGate<false> E{MG, GA};
          pg8::gemm_phase<EpiGate<false>, pg8::StaticOrder, true, false>(lds + RING_OFF, AM, WomT, 512, S, E, nullptr); }
        { pg8::StaticOrder S; S.init(TT, 1024, G, bx); EpiGate<true> E{MG, GB};
          pg8::gemm_phase<EpiGate<true>, pg8::StaticOrder, true, false>(lds + RING_OFF, AS, WosT, 512, S, E, nullptr); }
    }
    SEAM(4);
    if (IN(5)) {
        pg8::StaticOrder S; S.init(TT, 1024, G, bx); EpiOut E{Y1, x};
        pg8::gemm_phase<EpiOut, pg8::StaticOrder, true, false>(lds + RING_OFF, MG, WoutT, 1024, S, E, nullptr);
    }
    SEAM(5);
    if (IN(6)) {
        const float *g1 = args.in[10], *b1 = args.in[11];
        for (int m = gw; m < TT; m += NGW) { const f32x4* yr = (const f32x4*)(Y1 + (size_t)m * DM) + lane;
            f32x4 v[4]; float s = 0.f;
#pragma unroll
            for (int j = 0; j < 4; ++j) { v[j] = yr[64 * j]; s += (v[j][0] + v[j][1]) + (v[j][2] + v[j][3]); }
            const float mean = wave_sum(s) * (1.f / DM); float s2 = 0.f;
#pragma unroll
            for (int j = 0; j < 4; ++j) { v[j] = v[j] - mean; s2 += (v[j][0] * v[j][0] + v[j][1] * v[j][1]) + (v[j][2] * v[j][2] + v[j][3] * v[j][3]); }
            const float rstd = 1.f / sqrtf(wave_sum(s2) * (1.f / DM) + LN_EPS);
            f32x4* of = (f32x4*)(H1F + (size_t)m * DM) + lane; u32x2* ob = (u32x2*)(H1B + (size_t)m * DM) + lane;
#pragma unroll
            for (int j = 0; j < 4; ++j) { const f32x4 gg = ((const f32x4*)g1)[lane + 64 * j], bb = ((const f32x4*)b1)[lane + 64 * j]; const f32x4 o = v[j] * rstd * gg + bb;
                of[64 * j] = o; u32x2 w; w.x = cvtpk(o[0], o[1]); w.y = cvtpk(o[2], o[3]); ob[64 * j] = w; } }
    }
    SEAM(6);
    if (IN(7)) {
        pg8::StaticOrder S; S.init(TT, 256, G, bx); EpiRouter E{SC};
        pg8::gemm_phase<EpiRouter, pg8::StaticOrder, true, false>(lds + RING_OFF, H1B, WrT, 1024, S, E, nullptr);
    }
    SEAM(7);
    if (IN(8)) {
        const float* rbias = args.in[13];
        LAS int* hist = (LAS int*)(lds + RING_OFF); LAS int* base = hist + 256; LAS int* te = hist + 512; LAS float* tw = (LAS float*)(hist + 1536); LAS int* tlp = hist + 2560;
        for (int i = bx * 512 + tid; i < MAXROWS; i += G * 512) { RTOK[i] = 0; RSLOT[i] = -1; RW[i] = 0.f; }
        const f32x4 b4 = *(const f32x4*)(rbias + 4 * lane);
        for (int chunk = vcu; chunk < TT / 128; chunk += G) {
            __syncthreads();
            if (tid < 256) hist[tid] = 0;
            __syncthreads();
            for (int j = 0; j < 16; ++j) { const int tl = wave * 16 + j, t = chunk * 128 + tl;
                const f32x4 s4 = *(const f32x4*)(SC + (size_t)t * 256 + 4 * lane);
                float c0 = s4[0] + b4[0], c1 = s4[1] + b4[1], c2 = s4[2] + b4[2], c3 = s4[3] + b4[3];
                float m1, m2; { const float a = fmaxf(c0, c1), b = fminf(c0, c1), d = fmaxf(c2, c3), e = fminf(c2, c3); m1 = fmaxf(a, d); m2 = fmaxf(fminf(a, d), fmaxf(b, e)); }
#pragma unroll
                for (int o = 1; o < 8; o <<= 1) { const float o1 = __shfl_xor(m1, o), o2 = __shfl_xor(m2, o); const float n1 = fmaxf(m1, o1), n2 = fmaxf(fminf(m1, o1), fmaxf(m2, o2)); m1 = n1; m2 = n2; }
                const float gs = m1 + m2; const int g = lane >> 3; int rank = 0;
#pragma unroll
                for (int gg = 0; gg < 8; ++gg) { const float og = __shfl(gs, gg * 8); rank += (og > gs || (og == gs && gg < g)) ? 1 : 0; }
                if (rank >= 4) { c0 = -INFINITY; c1 = -INFINITY; c2 = -INFINITY; c3 = -INFINITY; }
                int myidx = 0;
#pragma unroll 1
                for (int k = 0; k < 8; ++k) {
                    float bv = c0; int bi = 4 * lane;
                    if (c1 > bv) { bv = c1; bi = 4 * lane + 1; } if (c2 > bv) { bv = c2; bi = 4 * lane + 2; } if (c3 > bv) { bv = c3; bi = 4 * lane + 3; }
#pragma unroll
                    for (int o = 1; o < 64; o <<= 1) { const float ov = __shfl_xor(bv, o); const int oi = __shfl_xor(bi, o); if (ov > bv || (ov == bv && oi < bi)) { bv = ov; bi = oi; } }
                    if ((bi >> 2) == lane) { const int q = bi & 3; if (q == 0) c0 = -INFINITY; else if (q == 1) c1 = -INFINITY; else if (q == 2) c2 = -INFINITY; else c3 = -INFINITY; }
                    if (lane == k) myidx = bi;
                }
                float sw = (lane < 8) ? SC[(size_t)t * 256 + myidx] : 0.f;
                float ssum = sw; ssum += __shfl_xor(ssum, 1); ssum += __shfl_xor(ssum, 2); ssum += __shfl_xor(ssum, 4);
                if (lane < 8) { const int lp = __hip_atomic_fetch_add(hist + myidx, 1, __ATOMIC_RELAXED, __HIP_MEMORY_SCOPE_WORKGROUP);
                    te[tl * 8 + lane] = myidx; tw[tl * 8 + lane] = sw / ssum * 2.5f; tlp[tl * 8 + lane] = lp; }
            }
            __syncthreads();
            if (tid < 256) { const int hc = hist[tid]; base[tid] = hc ? (int)__hip_atomic_fetch_add(CNT + tid, (unsigned)hc, RLX_AGENT) : 0; }
            __syncthreads();
            for (int p = tid; p < 1024; p += 512) { const int e = te[p]; const size_t o = (size_t)(chunk * 128) * 8 + p; TOPI[o] = e; TOPW[o] = tw[p]; TPOS[o] = base[e] + tlp[p]; }
        }
    }
    SEAM(8);
    if (IN(9)) {
        compute_tileoff(lds, CNT, tid);
        const LAS int* to = (const LAS int*)(lds + TILEOFF_OFF);
        for (int p = bx * 512 + tid; p < TT * 8; p += G * 512) { const int e = TOPI[p]; const int row = to[e] * 256 + TPOS[p]; const int t = p >> 3;
            RTOK[row] = t; RSLOT[row] = t * 9 + (p & 7); RW[row] = TOPW[p]; }
        const int sh0 = to[NEXP] * 256;
        for (int t = bx * 512 + tid; t < TT; t += G * 512) { RTOK[sh0 + t] = t; RSLOT[sh0 + t] = t * 9 + 8; RW[sh0 + t] = 1.0f; }
    }
    SEAM(9);
    if (IN(10)) {
        compute_tileoff(lds, CNT, tid);
        const LAS int* to = (const LAS int*)(lds + TILEOFF_OFF);
        LAS int* rowtab = (LAS int*)(lds + ROWTAB_OFF);
        pg8::GroupOrder S; S.init(to[NE1], 2, G, bx, to);
        for (int i = 0; i < ROWTAB_UNITS; ++i) { pg8::Unit u; if (!S.next(i, u)) break; if (tid < 256) rowtab[i * 256 + tid] = RTOK[u.pm * 256 + tid]; }
        __syncthreads();
        EpiUp E{HID};
        pg8::gemm_phase<EpiUp, pg8::GroupOrder, true, true>(lds + RING_OFF, H1B, WupT, 1024, S, E, rowtab);
    }
    SEAM(10);
    if (IN(11)) {
        compute_tileoff(lds, CNT, tid);
        const LAS int* to = (const LAS int*)(lds + TILEOFF_OFF);
        pg8::GroupOrder S; S.init(to[NE1], 4, G, bx, to);
        EpiDown E{YS, RSLOT, RW};
        pg8::gemm_phase<EpiDown, pg8::GroupOrder, true, false>(lds + RING_OFF, HID, WdnT, 256, S, E, nullptr);
    }
    SEAM(11);
    if (IN(12)) {
        const float *g2 = args.in[18], *b2 = args.in[19];
        for (int m = gw; m < TT; m += NGW) {
            f32x4 v[2][2];
#pragma unroll
            for (int j = 0; j < 2; ++j) { const float* hr = H1F + (size_t)m * DM + 8 * lane + 512 * j; v[j][0] = *(const f32x4*)hr * ALPHA; v[j][1] = *(const f32x4*)(hr + 4) * ALPHA; }
#pragma unroll
            for (int k = 0; k < 9; ++k)
#pragma unroll
                for (int j = 0; j < 2; ++j) { const u32x4 y = *(const u32x4*)(YS + ((size_t)m * 9 + k) * 1024 + 8 * lane + 512 * j);
                    v[j][0][0] += bflo(y.x); v[j][0][1] += bfhi(y.x); v[j][0][2] += bflo(y.y); v[j][0][3] += bfhi(y.y); v[j][1][0] += bflo(y.z); v[j][1][1] += bfhi(y.z); v[j][1][2] += bflo(y.w); v[j][1][3] += bfhi(y.w); }
            float s = 0.f;
#pragma unroll
            for (int j = 0; j < 2; ++j)
#pragma unroll
                for (int q = 0; q < 2; ++q) s += (v[j][q][0] + v[j][q][1]) + (v[j][q][2] + v[j][q][3]);
            const float mean = wave_sum(s) * (1.f / DM); float s2 = 0.f;
#pragma unroll
            for (int j = 0; j < 2; ++j)
#pragma unroll
                for (int q = 0; q < 2; ++q) { v[j][q] = v[j][q] - mean; s2 += (v[j][q][0] * v[j][q][0] + v[j][q][1] * v[j][q][1]) + (v[j][q][2] * v[j][q][2] + v[j][q][3] * v[j][q][3]); }
            const float rstd = 1.f / sqrtf(wave_sum(s2) * (1.f / DM) + LN_EPS);
#pragma unroll
            for (int j = 0; j < 2; ++j)
#pragma unroll
                for (int q = 0; q < 2; ++q) { const int c = 8 * lane + 512 * j + 4 * q; const f32x4 gg = *(const f32x4*)(g2 + c), bb = *(const f32x4*)(b2 + c);
                    *(f32x4*)(args.out + (size_t)m * DM + c) = v[j][q] * rstd * gg + bb; }
        }
    }
#undef IN
#undef SEAM
}

extern "C" void kernel_launch(void* const* d_in, const int* in_sizes, int n_in, void* d_out, int out_size, void* d_ws, size_t ws_size, hipStream_t stream) {
    static int grid = 0;
    if (grid == 0) {
        if (n_in != 20 || in_sizes[0] != TT * DM || out_size != TT * DM || ws_size < WS_END) { fprintf(stderr, "kernel_launch: unexpected shapes / workspace (%d inputs, ws %zu < %zu)\n", n_in, ws_size, (size_t)WS_END); grid = -1; return; }
        int dev = 0, cus = 0, per_cu = 0;
        if (hipGetDevice(&dev) != hipSuccess || hipDeviceGetAttribute(&cus, hipDeviceAttributeMultiprocessorCount, dev) != hipSuccess) { grid = -1; return; }
        if (hipFuncSetAttribute((const void*)mk_fwd, hipFuncAttributeMaxDynamicSharedMemorySize, LDS_BYTES) != hipSuccess) { fprintf(stderr, "kernel_launch: hipFuncSetAttribute failed\n"); grid = -1; return; }
        if (hipOccupancyMaxActiveBlocksPerMultiprocessor(&per_cu, (const void*)mk_fwd, 512, LDS_BYTES) != hipSuccess || per_cu < 1) { fprintf(stderr, "kernel_launch: occupancy query says %d\n", per_cu); per_cu = 1; }
        (void)hipGetLastError();
        grid = cus;
    }
    if (grid < 0) return;
    (void)hipMemsetAsync((char*)d_ws + WS_CTL, 0, CTL_ZERO_BYTES, stream);
    Args a{};
    for (int i = 0; i < 20; ++i) a.in[i] = (const float*)d_in[i];
    a.out = (float*)d_out; a.ws = (unsigned char*)d_ws;
    if (MK_N_LAUNCHES == 1) { a.ph_lo = 0; a.ph_hi = 13; hipLaunchKernelGGL(mk_fwd, dim3(grid), dim3(512), LDS_BYTES, stream, a); }
    else for (int p = 0; p < 13; ++p) { a.ph_lo = p; a.ph_hi = p + 1; hipLaunchKernelGGL(mk_fwd, dim3(grid), dim3(512), LDS_BYTES, stream, a); }
}
```

```cpp
#include <hip/hip_runtime.h>
#include <cstdio>
#include <cstdint>

#ifndef PROBE_A
#define PROBE_A -1
#endif
#ifndef PROBE_B
#define PROBE_B -1
#endif
#ifndef PROBE_G
#define PROBE_G -1
#endif
#ifndef MK_N_LAUNCHES
#define MK_N_LAUNCHES 1
#endif

#define LAS __attribute__((address_space(3)))
#define GAS __attribute__((address_space(1)))
typedef unsigned short bf16_t;
typedef short bf16x8 __attribute__((ext_vector_type(8)));
typedef short s16x4 __attribute__((ext_vector_type(4)));
typedef float f32x4 __attribute__((ext_vector_type(4)));
typedef float f32x2 __attribute__((ext_vector_type(2)));
typedef float f32x16 __attribute__((ext_vector_type(16)));
typedef unsigned u32x4 __attribute__((ext_vector_type(4)));
typedef unsigned u32x2 __attribute__((ext_vector_type(2)));
typedef __bf16 bf16x2_t __attribute__((ext_vector_type(2)));

constexpr int TT = 32768, DM = 1024, SEQ = 2048, NB = 16;
constexpr int NIN = 3584;
constexpr int NEXP = 256, NE1 = 257;
constexpr int MAXROWS = 360704;
constexpr float ALPHA = 1.189207115002721f;
constexpr float LOG2E = 1.4426950408889634f;
constexpr float C2M = 0.10206207261596575f * LOG2E;
constexpr float QSC = 0.125f * LOG2E;
constexpr float LN_EPS = 1e-5f, RMS_EPS = 1e-6f;

constexpr size_t MiB = 1u << 20;
constexpr size_t WS_CTL = 0, CTL_ZERO_BYTES = 1 * MiB;
constexpr size_t WS_ROPE = 1 * MiB;
constexpr size_t WS_WIN = 2 * MiB, WS_WUQ = 9 * MiB, WS_WUKV = 10 * MiB, WS_WOM = 11 * MiB, WS_WOS = 12 * MiB, WS_WOUT = 13 * MiB, WS_WR = 15 * MiB;
constexpr size_t WS_WUP = 16 * MiB, WS_WDN = 273 * MiB;
constexpr size_t WS_TOPI = 403 * MiB, WS_TOPW = 404 * MiB, WS_TPOS = 405 * MiB, WS_RTOK = 406 * MiB, WS_TROW = 408 * MiB;
constexpr size_t WS_SSQ = 402 * MiB;
constexpr size_t WS_SC = 412 * MiB, WS_H1F = 444 * MiB, WS_H1B = 572 * MiB, WS_HID = 636 * MiB;
constexpr size_t WS_R = 813 * MiB;
constexpr size_t WS_XB = WS_R, WS_CQ = WS_R + 64 * MiB, WS_CKV = WS_R + 80 * MiB, WS_QS = WS_R + 96 * MiB, WS_KS = WS_R + 128 * MiB, WS_VS = WS_R + 136 * MiB,
                 WS_GA = WS_R + 144 * MiB, WS_GB = WS_R + 208 * MiB, WS_QF = WS_R + 272 * MiB, WS_KF = WS_R + 320 * MiB, WS_VM = WS_R + 368 * MiB,
                 WS_AM = WS_R + 400 * MiB, WS_AS = WS_R + 432 * MiB, WS_MG = WS_R + 464 * MiB, WS_Y1 = WS_R + 528 * MiB;
constexpr size_t WS_Y = WS_R;
constexpr size_t WS_END = WS_R + 705 * MiB;
constexpr int CW_BAR = 4096;
constexpr int CW_CNT = 16384;
constexpr int CW_TS = 20480;

constexpr int RING_OFF = 0, RING_BYTES = 131072;
constexpr int LDSCTL_OFF = RING_BYTES, MISC_OFF = LDSCTL_OFF + 320;
constexpr int TILEOFF_OFF = 131584;
constexpr int ROWTAB_OFF = 133120, ROWTAB_UNITS = 24;
constexpr int LDS_BYTES = 163840;
static_assert(ROWTAB_OFF + ROWTAB_UNITS * 1024 <= LDS_BYTES, "lds");

#define RLX_AGENT __ATOMIC_RELAXED, __HIP_MEMORY_SCOPE_AGENT
#define LDS_WAIT() asm volatile("s_waitcnt lgkmcnt(0)" ::: "memory")
#define VM_WAIT() asm volatile("s_waitcnt vmcnt(0)" ::: "memory")

__device__ __forceinline__ unsigned cvtpk(float lo, float hi) { f32x2 v = {lo, hi}; bf16x2_t b = __builtin_convertvector(v, bf16x2_t); return __builtin_bit_cast(unsigned, b); }
__device__ __forceinline__ float bf2f(unsigned short h) { return __builtin_bit_cast(float, (unsigned)h << 16); }
__device__ __forceinline__ float bflo(unsigned w) { return __builtin_bit_cast(float, w << 16); }
__device__ __forceinline__ float bfhi(unsigned w) { return __builtin_bit_cast(float, w & 0xffff0000u); }
__device__ __forceinline__ float sigmoidf_(float v) { return __builtin_amdgcn_rcpf(1.0f + __builtin_amdgcn_exp2f(-v * LOG2E)); }

namespace pg8 {
constexpr int BM = 256, BK = 64, HALF = 128, HTB = HALF * BK * 2, STAGE_BYTES = 8 * HTB, NXCD = 8, WGM = 8;
__host__ __device__ __forceinline__ int lds_byte(int r, int c) { const int st = (r >> 4) * 2 + (c >> 5), rr = r & 15, cc = c & 31, ob = rr * 64 + cc * 2; return st * 1024 + (ob ^ (((ob >> 9) & 1) << 5)); }
__host__ __device__ __forceinline__ void stage_rc(int b, int& R, int& C) { const int st = b / 1024, sb = b % 1024, swz = sb ^ (((sb >> 9) & 1) << 5); R = (st >> 1) * 16 + swz / 64; C = (st & 1) * 32 + (swz % 64) / 2; }
__host__ __device__ __forceinline__ int perm32(int rho) { const int n = rho >> 4, i = rho & 15; return 8 * (i >> 2) + 4 * n + (i & 3); }

struct Unit { int pm, pn; };

__device__ __forceinline__ int xcd_remap(int L, int nwg) { const int q = nwg / NXCD, r = nwg % NXCD, xcd = L % NXCD, off = L / NXCD; return (xcd < r ? xcd * (q + 1) : r * (q + 1) + (xcd - r) * q) + off; }

struct StaticOrder {
    int nM, nN, nwg, G, c;
    __device__ void init(int M, int N, int G_, int c_) { nM = M / BM; nN = N / BM; nwg = nM * nN; G = G_; c = c_; }
    __device__ bool next(int i, Unit& u) const {
        const long L = (long)i * G + c; if (L >= nwg) return false;
        const int wgid = xcd_remap((int)L, nwg);
        const int nig = WGM * nN, gid = wgid / nig, fm = gid * WGM, gsz = (nM - fm) < WGM ? (nM - fm) : WGM;
        u.pm = fm + ((wgid % nig) % gsz); u.pn = (wgid % nig) / gsz; return true;
    }
};
struct GroupOrder {
    int ntiles, nN, nwg, G, c; const LAS int* tileoff;
    __device__ void init(int ntiles_, int nN_, int G_, int c_, const LAS int* to) { ntiles = ntiles_; nN = nN_; nwg = ntiles * nN; G = G_; c = c_; tileoff = to; }
    __device__ bool next(int i, Unit& u) const {
        const long L = (long)i * G + c; if (L >= nwg) return false;
        const int wgid = xcd_remap((int)L, nwg);
        const int tau = wgid / nN, pn = wgid % nN;
        int lo = 0, hi = NE1;
        while (hi - lo > 1) { const int mid = (lo + hi) >> 1; if (tileoff[mid] <= tau) lo = mid; else hi = mid; }
        u.pm = tau; u.pn = lo * nN + pn; return true;
    }
};

template <class Epi, class Sched, bool ALIGN_EPI, bool GATHER, bool TPROBE = false>
__device__ __forceinline__ void gemm_phase(LAS unsigned char* lds, const bf16_t* Abase, const bf16_t* Btbase, const int K, const Sched& S, const Epi& E, const LAS int* rowtab, unsigned* tsout = nullptr) {
    unsigned long long tk = 0, te = 0, tt = 0, t0 = 0, t1 = 0;
    const int tid = threadIdx.x, wid = __builtin_amdgcn_readfirstlane(tid >> 6), lane = tid & 63, wr = wid >> 2, wc = wid & 3, fr = lane & 15, fq = lane >> 4;
    const int nt = K / BK;
    unsigned voffB[2][2];
#pragma unroll
    for (int h = 0; h < 2; ++h)
#pragma unroll
        for (int i = 0; i < 2; ++i) { int R, C; stage_rc(tid * 16 + i * 8192, R, C);
            const int col = (Epi::PERM == 2) ? (64 * (R >> 5) + 16 * ((R >> 2) & 3) + 8 * h + 4 * ((R >> 4) & 1) + (R & 3)) : (128 * h + ((Epi::PERM == 1) ? ((R & ~31) + perm32(R & 31)) : R));
            voffB[h][i] = (unsigned)(col * K + C) * 2u; }
    const size_t kstep = (size_t)(BK * 2);
    const size_t hstep = (size_t)HALF * K * 2;
    const size_t tstep = 2 * hstep;
    const unsigned ldsw = (unsigned)wid * 1024u;
    const int aoff = lds_byte(wr * 64 + fr, fq * 8), boff = lds_byte(wc * 32 + fr, fq * 8);
    const char* Ab = (const char*)Abase;
#define PG8_SA(b, h) (((b) * 2 + (h)) * HTB)
#define PG8_SB(b, h) ((4 + (b) * 2 + (h)) * HTB)
#define PG8_STAGE(bufoff, gbase, voff) do { _Pragma("unroll") for (int _i = 0; _i < 2; ++_i) \
        __builtin_amdgcn_global_load_lds((const unsigned*)((const char*)(gbase) + (voff)[_i]), (LAS unsigned*)(lds + (bufoff) + ldsw + _i * 8192), 16, 0, 0); } while (0)
#define PG8_LDA(dst, b, h) do { _Pragma("unroll") for (int m = 0; m < 4; ++m) _Pragma("unroll") for (int k = 0; k < 2; ++k) dst[m][k] = *(const LAS bf16x8*)(lds + PG8_SA(b, h) + aoff + m * 2048 + k * 1024); } while (0)
#define PG8_LDB(dst, b, h) do { _Pragma("unroll") for (int n = 0; n < 2; ++n) _Pragma("unroll") for (int k = 0; k < 2; ++k) dst[n][k] = *(const LAS bf16x8*)(lds + PG8_SB(b, h) + boff + n * 2048 + k * 1024); } while (0)
#define PG8_MMA(ai, bj, At, Bt) do { __builtin_amdgcn_s_setprio(1); _Pragma("unroll") for (int m = 0; m < 4; ++m) _Pragma("unroll") for (int n = 0; n < 2; ++n) _Pragma("unroll") for (int k = 0; k < 2; ++k) \
        acc[ai][bj][m][n] = __builtin_amdgcn_mfma_f32_16x16x32_bf16(Bt[n][k], At[m][k], acc[ai][bj][m][n], 0, 0, 0); __builtin_amdgcn_s_setprio(0); } while (0)
#define PG8_WAIT_V(n) asm volatile("s_waitcnt vmcnt(" #n ")" ::: "memory")
#define PG8_WAIT_L(n) asm volatile("s_waitcnt lgkmcnt(" #n ")" ::: "memory")
#define PG8_BAR __builtin_amdgcn_s_barrier()
#define PG8_SCHED __builtin_amdgcn_sched_barrier(0)
#define PG8_MKVA(va, u, ui_) do { _Pragma("unroll") for (int _h = 0; _h < 2; ++_h) _Pragma("unroll") for (int _i = 0; _i < 2; ++_i) { int _R, _C; stage_rc(tid * 16 + _i * 8192, _R, _C); \
        const int _row = GATHER ? rowtab[(ui_) * 256 + _h * 128 + _R] : ((u).pm * 256 + _h * 128 + _R); (va)[_h][_i] = (unsigned)(_row * K + _C) * 2u; } } while (0)
    Unit cur, nxt; int ui = 0;
    if (!S.next(0, cur)) return;
    f32x4 acc[2][2][4][2];
#pragma unroll
    for (int a = 0; a < 2; ++a)
#pragma unroll
        for (int b = 0; b < 2; ++b)
#pragma unroll
            for (int m = 0; m < 4; ++m)
#pragma unroll
                for (int n = 0; n < 2; ++n) acc[a][b][m][n] = (f32x4){0.f, 0.f, 0.f, 0.f};
    bf16x8 At[4][2], B0[2][2], B1[2][2];
    unsigned vaC[2][2];
    PG8_MKVA(vaC, cur, 0);
    const char* cB = (const char*)Btbase + (size_t)cur.pn * tstep;
    PG8_STAGE(PG8_SB(0, 0), cB, voffB[0]); PG8_STAGE(PG8_SB(0, 1), cB, voffB[1]); PG8_STAGE(PG8_SA(0, 0), Ab, vaC[0]); PG8_STAGE(PG8_SA(0, 1), Ab, vaC[1]);
    if (wr == 1) PG8_BAR;
    PG8_WAIT_V(2); PG8_BAR;
    PG8_STAGE(PG8_SB(1, 0), cB + kstep, voffB[0]); PG8_STAGE(PG8_SA(1, 0), Ab + kstep, vaC[0]); PG8_STAGE(PG8_SB(1, 1), cB + kstep, voffB[1]);
    PG8_WAIT_V(6); PG8_BAR;
    for (;;) {
        if (TPROBE) t0 = __builtin_amdgcn_s_memrealtime();
        const bool has_next = S.next(ui + 1, nxt);
        const char* nB = has_next ? (const char*)Btbase + (size_t)nxt.pn * tstep : cB;
#pragma unroll 1
        for (int t = 0; t < nt; t += 2) {
            const bool last = (t == nt - 2);
            const char* a1 = Ab + (size_t)(t + 1) * kstep;
            const char* a2 = last ? Ab : Ab + (size_t)(t + 2) * kstep; const char* b2 = last ? nB : cB + (size_t)(t + 2) * kstep;
            const char* a3 = a2 + kstep; const char* b3 = b2 + kstep;
            unsigned vx[2][2];
            if (last && has_next) { PG8_MKVA(vx, nxt, ui + 1); } else {
#pragma unroll
                for (int h = 0; h < 2; ++h)
#pragma unroll
                    for (int i = 0; i < 2; ++i) vx[h][i] = vaC[h][i]; }
            PG8_LDB(B0, 0, 0); PG8_LDB(B1, 0, 1); PG8_SCHED; PG8_LDA(At, 0, 0); PG8_STAGE(PG8_SA(1, 1), a1, vaC[1]);
            PG8_WAIT_V(8); PG8_WAIT_L(0); PG8_BAR; PG8_MMA(0, 0, At, B0); PG8_MMA(0, 1, At, B1); PG8_BAR; PG8_SCHED;
            PG8_LDA(At, 0, 1); PG8_STAGE(PG8_SB(0, 0), b2, voffB[0]); PG8_STAGE(PG8_SB(0, 1), b2, voffB[1]); PG8_STAGE(PG8_SA(0, 0), a2, vx[0]);
            PG8_WAIT_V(8); PG8_WAIT_L(0); PG8_BAR; PG8_MMA(1, 0, At, B0); PG8_MMA(1, 1, At, B1); PG8_BAR; PG8_SCHED;
            PG8_LDB(B0, 1, 0); PG8_LDB(B1, 1, 1); PG8_SCHED; PG8_LDA(At, 1, 0); PG8_STAGE(PG8_SA(0, 1), a2, vx[1]);
            PG8_WAIT_V(8); PG8_WAIT_L(0); PG8_BAR; PG8_MMA(0, 0, At, B0); PG8_MMA(0, 1, At, B1); PG8_BAR; PG8_SCHED;
            PG8_LDA(At, 1, 1); PG8_STAGE(PG8_SB(1, 0), b3, voffB[0]); PG8_STAGE(PG8_SB(1, 1), b3, voffB[1]); PG8_STAGE(PG8_SA(1, 0), a3, vx[0]);
            PG8_WAIT_V(8); PG8_WAIT_L(0); PG8_BAR; PG8_MMA(1, 0, At, B0); PG8_MMA(1, 1, At, B1); PG8_BAR; PG8_SCHED;
        }
        if (TPROBE) { t1 = __builtin_amdgcn_s_memrealtime(); tk += t1 - t0; }
        if constexpr (ALIGN_EPI) { if (wr == 0) PG8_BAR; }
        E(acc, cur, wr, wc, fr, fq);
        if (TPROBE) { t0 = __builtin_amdgcn_s_memrealtime(); te += t0 - t1; }
        if (!has_next) break;
#pragma unroll
        for (int a = 0; a < 2; ++a)
#pragma unroll
            for (int b = 0; b < 2; ++b)
#pragma unroll
                for (int m = 0; m < 4; ++m)
#pragma unroll
                    for (int n = 0; n < 2; ++n) acc[a][b][m][n] = (f32x4){0.f, 0.f, 0.f, 0.f};
        cur = nxt; cB = nB; ++ui;
        PG8_MKVA(vaC, cur, ui);
        if constexpr (ALIGN_EPI) { if (wr == 1) PG8_BAR; }
        if (TPROBE) { t1 = __builtin_amdgcn_s_memrealtime(); tt += t1 - t0; }
    }
    PG8_WAIT_V(0);
    if (TPROBE && tsout && tid == 0) { tsout[0] = (unsigned)tk; tsout[1] = (unsigned)te; tsout[2] = (unsigned)tt; }
    if constexpr (!ALIGN_EPI) { if (wr == 0) PG8_BAR; }
    PG8_BAR;
#undef PG8_SA
#undef PG8_SB
#undef PG8_STAGE
#undef PG8_LDA
#undef PG8_LDB
#undef PG8_MMA
#undef PG8_WAIT_V
#undef PG8_WAIT_L
#undef PG8_BAR
#undef PG8_SCHED
#undef PG8_MKVA
}
}

typedef f32x4 AccT[2][2][4][2];
#define EPI_LOOP_ROWS for (int ai = 0; ai < 2; ++ai) _Pragma("unroll") for (int m = 0; m < 4; ++m)
__device__ __forceinline__ u32x4 pack8(const f32x4 a, const f32x4 b) { u32x4 w; w.x = cvtpk(a[0], a[1]); w.y = cvtpk(a[2], a[3]); w.z = cvtpk(b[0], b[1]); w.w = cvtpk(b[2], b[3]); return w; }

struct EpiInProj {
    static constexpr int PERM = 1;
    bf16_t *CQ, *CKV, *QS, *KS, *VS, *KF, *GA, *GB; float *SSQQ, *SSQKV; const float* ROPE;
    __device__ __forceinline__ void operator()(const AccT& acc, const pg8::Unit& u, int wr, int wc, int fr, int fq) const {
        const int pn = u.pn, row0 = u.pm * 256 + wr * 64 + fr, cl = wc * 32 + 8 * fq;
        if (pn <= 1) {
            bf16_t* O = pn == 0 ? CQ : CKV; float* ssq = pn == 0 ? SSQQ : SSQKV;
#pragma unroll
            EPI_LOOP_ROWS { const int row = row0 + ai * 128 + m * 16; float s = 0.f;
#pragma unroll
                for (int bj = 0; bj < 2; ++bj) { const f32x4 v0 = acc[ai][bj][m][0], v1 = acc[ai][bj][m][1];
                    s += (v0[0] * v0[0] + v0[1] * v0[1]) + (v0[2] * v0[2] + v0[3] * v0[3]) + (v1[0] * v1[0] + v1[1] * v1[1]) + (v1[2] * v1[2] + v1[3] * v1[3]);
                    *(u32x4*)(O + (size_t)row * 256 + bj * 128 + cl) = pack8(v0, v1); }
                s += __shfl_xor(s, 16); s += __shfl_xor(s, 32);
                if (fq == 0) ssq[row * 4 + wc] = s; }
        } else if (pn <= 3) {
#pragma unroll
            EPI_LOOP_ROWS { const int row = row0 + ai * 128 + m * 16;
#pragma unroll
                for (int bj = 0; bj < 2; ++bj) *(u32x4*)(QS + (size_t)row * 512 + (pn - 2) * 256 + bj * 128 + cl) = pack8(acc[ai][bj][m][0] * QSC, acc[ai][bj][m][1] * QSC); }
        } else if (pn == 4) {
#pragma unroll
            EPI_LOOP_ROWS { const int row = row0 + ai * 128 + m * 16;
                *(u32x4*)(KS + (size_t)row * 128 + cl) = pack8(acc[ai][0][m][0], acc[ai][0][m][1]);
                *(u32x4*)(VS + (size_t)row * 128 + cl) = pack8(acc[ai][1][m][0], acc[ai][1][m][1]); }
        } else if (pn == 5) {
            if (wc == 0) {
#pragma unroll
                EPI_LOOP_ROWS { const int row = row0 + ai * 128 + m * 16; const int pos = row & (SEQ - 1);
                    const f32x4 c = *(const f32x4*)(ROPE + pos * 16 + 4 * fq), s = *(const f32x4*)(ROPE + SEQ * 16 + pos * 16 + 4 * fq);
                    const f32x4 x1 = acc[ai][0][m][0], x2 = acc[ai][0][m][1];
                    const u32x4 w = pack8(x1 * c - x2 * s, x1 * s + x2 * c);
#pragma unroll
                    for (int h = 0; h < 8; ++h) *(u32x4*)(KF + (size_t)row * 768 + h * 96 + 64 + 8 * fq) = w; }
            }
        } else {
            bf16_t* O = pn <= 9 ? GA + (pn - 6) * 256 : GB + (pn - 10) * 256;
#pragma unroll
            EPI_LOOP_ROWS { const int row = row0 + ai * 128 + m * 16;
#pragma unroll
                for (int bj = 0; bj < 2; ++bj) { f32x4 v0 = acc[ai][bj][m][0], v1 = acc[ai][bj][m][1];
#pragma unroll
                    for (int j = 0; j < 4; ++j) { v0[j] = sigmoidf_(v0[j]); v1[j] = sigmoidf_(v1[j]); }
                    *(u32x4*)(O + (size_t)row * 1024 + bj * 128 + cl) = pack8(v0, v1); } }
        }
    }
};
struct EpiQ {
    static constexpr int PERM = 1;
    bf16_t* QF; const float* SSQQ; const float* ROPE;
    __device__ __forceinline__ void operator()(const AccT& acc, const pg8::Unit& u, int wr, int wc, int fr, int fq) const {
        const int row0 = u.pm * 256 + wr * 64 + fr, cl = wc * 32 + 8 * fq;
#pragma unroll
        EPI_LOOP_ROWS { const int row = row0 + ai * 128 + m * 16; const int pos = row & (SEQ - 1);
            const f32x4 sq = *(const f32x4*)(SSQQ + row * 4); const float rs = __builtin_amdgcn_rsqf(((sq[0] + sq[1]) + (sq[2] + sq[3])) * (1.0f / 256.0f) + RMS_EPS) * C2M;
#pragma unroll
            for (int bj = 0; bj < 2; ++bj) { const int g32 = u.pn * 8 + bj * 4 + wc;
                f32x4 v0 = acc[ai][bj][m][0] * rs, v1 = acc[ai][bj][m][1] * rs;
                if (g32 % 3 == 2) { const f32x4 c = *(const f32x4*)(ROPE + pos * 16 + 4 * fq), s = *(const f32x4*)(ROPE + SEQ * 16 + pos * 16 + 4 * fq);
                    const f32x4 a = v0 * c - v1 * s, b = v0 * s + v1 * c; v0 = a; v1 = b; }
                *(u32x4*)(QF + (size_t)row * 768 + u.pn * 256 + bj * 128 + cl) = pack8(v0, v1); } }
    }
};
struct EpiKV {
    static constexpr int PERM = 1;
    bf16_t *KF, *VM; const float* SSQKV;
    __device__ __forceinline__ void operator()(const AccT& acc, const pg8::Unit& u, int wr, int wc, int fr, int fq) const {
        const int row0 = u.pm * 256 + wr * 64 + fr;
#pragma unroll
        EPI_LOOP_ROWS { const int row = row0 + ai * 128 + m * 16;
            const f32x4 sq = *(const f32x4*)(SSQKV + row * 4); const float rs = __builtin_amdgcn_rsqf(((sq[0] + sq[1]) + (sq[2] + sq[3])) * (1.0f / 256.0f) + RMS_EPS);
#pragma unroll
            for (int bj = 0; bj < 2; ++bj) { const int h = u.pn * 2 + bj; const u32x4 w = pack8(acc[ai][bj][m][0] * rs, acc[ai][bj][m][1] * rs);
                if (wc < 2) *(u32x4*)(KF + (size_t)row * 768 + h * 96 + wc * 32 + 8 * fq) = w;
                else        *(u32x4*)(VM + (size_t)row * 512 + h * 64 + (wc - 2) * 32 + 8 * fq) = w; } }
    }
};
template <bool SECOND> struct EpiGate {
    static constexpr int PERM = 1;
    bf16_t* MG; const bf16_t* G;
    __device__ __forceinline__ void operator()(const AccT& acc, const pg8::Unit& u, int wr, int wc, int fr, int fq) const {
        const int row0 = u.pm * 256 + wr * 64 + fr, col0 = u.pn * 256 + wc * 32 + 8 * fq;
#pragma unroll
        EPI_LOOP_ROWS { const int row = row0 + ai * 128 + m * 16;
#pragma unroll
            for (int bj = 0; bj < 2; ++bj) { const size_t off = (size_t)row * 1024 + col0 + bj * 128;
                const u32x4 g = *(const u32x4*)(G + off);
                f32x4 v0 = acc[ai][bj][m][0], v1 = acc[ai][bj][m][1];
                v0[0] *= bflo(g.x); v0[1] *= bfhi(g.x); v0[2] *= bflo(g.y); v0[3] *= bfhi(g.y); v1[0] *= bflo(g.z); v1[1] *= bfhi(g.z); v1[2] *= bflo(g.w); v1[3] *= bfhi(g.w);
                if (SECOND) { const u32x4 p = *(const u32x4*)(MG + off);
                    v0[0] += bflo(p.x); v0[1] += bfhi(p.x); v0[2] += bflo(p.y); v0[3] += bfhi(p.y); v1[0] += bflo(p.z); v1[1] += bfhi(p.z); v1[2] += bflo(p.w); v1[3] += bfhi(p.w); }
                *(u32x4*)(MG + off) = pack8(v0, v1); } }
    }
};
struct EpiOut {
    static constexpr int PERM = 0;
    float* Y1; const float* X;
    __device__ __forceinline__ void operator()(const AccT& acc, const pg8::Unit& u, int wr, int wc, int fr, int fq) const {
        const int row0 = u.pm * 256 + wr * 64 + fr, col0 = u.pn * 256 + wc * 32 + 4 * fq;
#pragma unroll
        EPI_LOOP_ROWS { const size_t ro = (size_t)(row0 + ai * 128 + m * 16) * 1024 + col0;
#pragma unroll
            for (int bj = 0; bj < 2; ++bj)
#pragma unroll
                for (int n = 0; n < 2; ++n) { const size_t off = ro + bj * 128 + n * 16; const f32x4 xv = *(const f32x4*)(X + off); *(f32x4*)(Y1 + off) = xv * ALPHA + acc[ai][bj][m][n]; } }
    }
};
struct EpiRouter {
    static constexpr int PERM = 0;
    float* SC;
    __device__ __forceinline__ void operator()(const AccT& acc, const pg8::Unit& u, int wr, int wc, int fr, int fq) const {
        const int row0 = u.pm * 256 + wr * 64 + fr, col0 = wc * 32 + 4 * fq;
#pragma unroll
        EPI_LOOP_ROWS { const size_t ro = (size_t)(row0 + ai * 128 + m * 16) * 256 + col0;
#pragma unroll
            for (int bj = 0; bj < 2; ++bj)
#pragma unroll
                for (int n = 0; n < 2; ++n) { f32x4 v = acc[ai][bj][m][n];
#pragma unroll
                    for (int j = 0; j < 4; ++j) v[j] = sigmoidf_(v[j]);
                    *(f32x4*)(SC + ro + bj * 128 + n * 16) = v; } }
    }
};
struct EpiUp {
    static constexpr int PERM = 1;
    bf16_t* HID;
    __device__ __forceinline__ void operator()(const AccT& acc, const pg8::Unit& u, int wr, int wc, int fr, int fq) const {
        const int row0 = u.pm * 256 + wr * 64 + fr, col0 = (u.pn & 1) * 128 + wc * 32 + 8 * fq;
#pragma unroll
        EPI_LOOP_ROWS { const int row = row0 + ai * 128 + m * 16; f32x4 h0, h1;
#pragma unroll
            for (int j = 0; j < 4; ++j) { const float g0 = acc[ai][0][m][0][j], g1 = acc[ai][0][m][1][j];
                h0[j] = g0 * sigmoidf_(g0) * acc[ai][1][m][0][j]; h1[j] = g1 * sigmoidf_(g1) * acc[ai][1][m][1][j]; }
            *(u32x4*)(HID + (size_t)row * 256 + col0) = pack8(h0, h1); }
    }
};
struct EpiDown {
    static constexpr int PERM = 2;
    unsigned char* Y;
    __device__ __forceinline__ void operator()(const AccT& acc, const pg8::Unit& u, int wr, int wc, int fr, int fq) const {
        const int row0 = u.pm * 256 + wr * 64 + fr, col0 = (u.pn & 3) * 256 + wc * 64 + 16 * fq;
#pragma unroll
        EPI_LOOP_ROWS { const int row = row0 + ai * 128 + m * 16; u32x4 w;
#pragma unroll
            for (int bj = 0; bj < 2; ++bj)
#pragma unroll
                for (int n = 0; n < 2; ++n) { const f32x4 v = acc[ai][bj][m][n]; unsigned p = 0u;
                    p = __builtin_amdgcn_cvt_pk_fp8_f32(v[0], v[1], p, false); p = __builtin_amdgcn_cvt_pk_fp8_f32(v[2], v[3], p, true); w[bj * 2 + n] = p; }
            *(u32x4*)(Y + (size_t)row * 1024 + col0) = w; }
    }
};

__device__ __forceinline__ s16x4 vtr(const LAS unsigned char* p) { return __builtin_bit_cast(s16x4, __builtin_amdgcn_ds_read_tr16_b64_v4i16((LAS s16x4*)p)); }
template <int DQK, bool SWA>
__device__ __forceinline__ void attn_unit(LAS unsigned char* lds, const bf16_t* Qh, int qp, const bf16_t* Kh, int kp, const bf16_t* Vh, int vp, bf16_t* Oh, int op,
                                          int pos0, int t_lo, int t_hi, float slope2, float sink2) {
    constexpr int NCH = DQK / 8, NDK = DQK / 16, KBY = NCH * 1024;
    constexpr int OFF_K = 0, OFF_V = 2 * KBY, OFF_SCR = 2 * KBY + 16384, OFF_OST = OFF_SCR + 2048;
    const int tid = threadIdx.x, lane = tid & 63, r32 = lane & 31, hi = lane >> 5; const int wid = __builtin_amdgcn_readfirstlane(tid >> 6);
    const int qmin = pos0 + wid * 32, qpos = qmin + r32, qmax = qmin + 31;
    bf16x8 qr[NDK];
    { const bf16_t* qrow = Qh + (size_t)qpos * qp;
#pragma unroll
      for (int d0 = 0; d0 < NDK; ++d0) qr[d0] = *(const bf16x8*)(qrow + d0 * 16 + hi * 8); }
    float m_run = -INFINITY, l_run = 0.f; f32x16 o0 = {}, o1 = {};
    LAS float* scr = (LAS float*)(lds + OFF_SCR) + wid * 64;
#define ATT_STAGE(t_, b_) do { \
        for (int c_ = wid; c_ < NCH; c_ += 8) __builtin_amdgcn_global_load_lds((const unsigned*)(Kh + (size_t)((t_) * 64 + lane) * kp + c_ * 8), (LAS unsigned*)(lds + OFF_K + (b_) * KBY + c_ * 1024), 16, 0, 0); \
        __builtin_amdgcn_global_load_lds((const unsigned*)(Vh + (size_t)((t_) * 64 + 16 * (wid & 3) + (lane >> 2)) * vp + (wid >> 2) * 32 + (lane & 3) * 8), (LAS unsigned*)(lds + OFF_V + (b_) * 8192 + wid * 1024), 16, 0, 0); } while (0)
    ATT_STAGE(t_lo, 0);
    for (int t = t_lo; t < t_hi; ++t) {
        const int buf = (t - t_lo) & 1;
        VM_WAIT(); __syncthreads();
        if (t + 1 < t_hi) ATT_STAGE(t + 1, buf ^ 1);
        const int kmin = t * 64, kmax = kmin + 63;
        const bool need = SWA ? (kmax >= qmin - 127 && kmin <= qmax) : (kmin <= qmax);
        if (need) {
            f32x16 p0 = {}, p1 = {};
            const LAS unsigned char* kb = lds + OFF_K + buf * KBY + hi * 1024 + r32 * 16;
#pragma unroll
            for (int d0 = 0; d0 < NDK; ++d0) { const bf16x8 b0 = *(const LAS bf16x8*)(kb + d0 * 2048), b1 = *(const LAS bf16x8*)(kb + d0 * 2048 + 512);
                p0 = __builtin_amdgcn_mfma_f32_32x32x16_bf16(b0, qr[d0], p0, 0, 0, 0); p1 = __builtin_amdgcn_mfma_f32_32x32x16_bf16(b1, qr[d0], p1, 0, 0, 0); }
            if (SWA) {
                const int dq = qpos - kmin - 4 * hi;
#pragma unroll
                for (int r = 0; r < 16; ++r) { const int d0_ = dq - ((r & 3) + 8 * (r >> 2)), d1_ = d0_ - 32;
                    p0[r] = (d0_ >= 0 && d0_ < 128) ? p0[r] - slope2 * (float)d0_ : -INFINITY;
                    p1[r] = (d1_ >= 0 && d1_ < 128) ? p1[r] - slope2 * (float)d1_ : -INFINITY; }
            } else if (kmax > qmin) {
                const int dq = qpos - kmin - 4 * hi;
#pragma unroll
                for (int r = 0; r < 16; ++r) { const int d0_ = dq - ((r & 3) + 8 * (r >> 2));
                    if (d0_ < 0) p0[r] = -INFINITY; if (d0_ < 32) p1[r] = -INFINITY; }
            }
            float rm = fmaxf(p0[0], p1[0]);
#pragma unroll
            for (int r = 1; r < 16; ++r) rm = fmaxf(rm, fmaxf(p0[r], p1[r]));
            rm = fmaxf(rm, __shfl_xor(rm, 32));
            const float mnew = fmaxf(m_run, rm), muse = (mnew == -INFINITY) ? 0.f : mnew;
            const float alpha = __builtin_amdgcn_exp2f(m_run - muse);
            float ls = 0.f;
#pragma unroll
            for (int r = 0; r < 16; ++r) { p0[r] = __builtin_amdgcn_exp2f(p0[r] - muse); p1[r] = __builtin_amdgcn_exp2f(p1[r] - muse); ls += p0[r] + p1[r]; }
            l_run = l_run * alpha + ls; m_run = mnew;
            if (!__all(alpha == 1.0f)) {
                if (hi == 0) scr[r32] = alpha;
                LDS_WAIT();
#pragma unroll
                for (int i = 0; i < 4; ++i) { const f32x4 a = *(const LAS f32x4*)(scr + 8 * i + 4 * hi);
#pragma unroll
                    for (int j = 0; j < 4; ++j) { o0[4 * i + j] *= a[j]; o1[4 * i + j] *= a[j]; } }
                LDS_WAIT();
            }
            u32x4 pw[4];
#pragma unroll
            for (int j = 0; j < 4; ++j) { pw[0][j] = cvtpk(p0[2 * j], p0[2 * j + 1]); pw[1][j] = cvtpk(p0[8 + 2 * j], p0[9 + 2 * j]); pw[2][j] = cvtpk(p1[2 * j], p1[2 * j + 1]); pw[3][j] = cvtpk(p1[8 + 2 * j], p1[9 + 2 * j]); }
            const LAS unsigned char* vb = lds + OFF_V + buf * 8192 + ((lane >> 4) & 1) * 32 + (lane & 3) * 8 + (4 * hi + ((lane & 15) >> 2)) * 64;
#pragma unroll
            for (int ks = 0; ks < 4; ++ks) {
                const s16x4 l0 = vtr(vb + ks * 1024), h0 = vtr(vb + ks * 1024 + 512), l1 = vtr(vb + 4096 + ks * 1024), h1 = vtr(vb + 4096 + ks * 1024 + 512);
                const bf16x8 v0 = (bf16x8){l0[0], l0[1], l0[2], l0[3], h0[0], h0[1], h0[2], h0[3]}, v1 = (bf16x8){l1[0], l1[1], l1[2], l1[3], h1[0], h1[1], h1[2], h1[3]};
                const bf16x8 pa = __builtin_bit_cast(bf16x8, pw[ks]);
                o0 = __builtin_amdgcn_mfma_f32_32x32x16_bf16(pa, v0, o0, 0, 0, 0); o1 = __builtin_amdgcn_mfma_f32_32x32x16_bf16(pa, v1, o1, 0, 0, 0); }
        }
    }
#undef ATT_STAGE
    float lt = l_run + __shfl_xor(l_run, 32), sc;
    if (SWA) { const float m2 = fmaxf(m_run, sink2), f = __builtin_amdgcn_exp2f(m_run - m2); sc = f / (lt * f + __builtin_amdgcn_exp2f(sink2 - m2)); }
    else sc = 1.0f / lt;
    if (hi == 0) scr[r32] = sc;
    LDS_WAIT();
    LAS bf16_t* stg = (LAS bf16_t*)(lds + OFF_OST) + wid * 2048;
#pragma unroll
    for (int i = 0; i < 4; ++i) { const f32x4 a = *(const LAS f32x4*)(scr + 8 * i + 4 * hi);
#pragma unroll
        for (int j = 0; j < 4; ++j) { const int orow = 8 * i + 4 * hi + j; const int r = 4 * i + j;
            stg[orow * 64 + r32] = (bf16_t)(cvtpk(o0[r] * a[j], 0.f) & 0xffffu); stg[orow * 64 + 32 + r32] = (bf16_t)(cvtpk(o1[r] * a[j], 0.f) & 0xffffu); } }
    LDS_WAIT();
#pragma unroll
    for (int i = 0; i < 4; ++i) { const int row = i * 8 + (lane >> 3), ch = lane & 7; const u32x4 v = *(const LAS u32x4*)(stg + row * 64 + ch * 8);
        *(u32x4*)(Oh + (size_t)(qmin + row) * op + ch * 8) = v; }
    LDS_WAIT(); __syncthreads();
}

#define XB_TMO      128
#define XB_XCNT(j)  (256  + 64 * (j))
#define XB_XSUB(j)  (1280 + 64 * (j))
#define XB_XGEN(j)  (2304 + 64 * (j))
#define XB_TOP      3328
#define XB_TOPGEN   3392
#define XCD_BAR_WORDS 3456
#define XB_SPIN_CAP (1u << 18)
__device__ __forceinline__ unsigned xb_ld(unsigned* p)              { return __hip_atomic_load(p, __ATOMIC_RELAXED, __HIP_MEMORY_SCOPE_AGENT); }
__device__ __forceinline__ unsigned xb_add(unsigned* p, unsigned v) { return __hip_atomic_fetch_add(p, v, __ATOMIC_RELAXED, __HIP_MEMORY_SCOPE_AGENT); }
__device__ __forceinline__ unsigned xb_xcc_id() { return (unsigned)__builtin_amdgcn_s_getreg((3 << 11) | 20) & 0xFu; }
#define XB_SPIN(cond, bar) do { unsigned _sp = 0; while (cond) { __builtin_amdgcn_s_sleep(1); \
    if ((++_sp & 255u) == 0u) { if (xb_ld(&(bar)[XB_TMO])) break; if (_sp > XB_SPIN_CAP) { atomicAdd(&(bar)[XB_TMO], 1u); break; } } } } while (0)
struct XcdBarrier { unsigned* bar; unsigned x; volatile LAS unsigned* st; };
__device__ __forceinline__ XcdBarrier xcd_barrier_post(unsigned* bar, volatile LAS unsigned* st) {
    XcdBarrier b; b.bar = bar; b.x = xb_xcc_id(); b.st = st;
    if (threadIdx.x == 0) (void)xb_add(&bar[XB_XCNT(b.x)], 1u);
    return b;
}
__device__ __forceinline__ void xcd_barrier_complete(unsigned* bar, unsigned x, unsigned& nloc, unsigned& nx) {
    const unsigned G = gridDim.x * gridDim.y * gridDim.z;
    unsigned sum, cnt, mine, sp = 0u;
    for (;;) {
        sum = 0u; cnt = 0u; mine = 0u;
#pragma unroll
        for (unsigned j = 0; j < 16; ++j) { const unsigned c = xb_ld(&bar[XB_XCNT(j)]); sum += c; cnt += (c > 0u) ? 1u : 0u; mine = (j == x) ? c : mine; }
        if (sum == G) break;
        __builtin_amdgcn_s_sleep(1);
        if ((++sp & 255u) == 0u) { if (xb_ld(&bar[XB_TMO])) break; if (sp > XB_SPIN_CAP) { atomicAdd(&bar[XB_TMO], 1u); break; } }
    }
    nloc = mine > 0u ? mine : 1u; nx = cnt > 0u ? cnt : 1u;
}
__device__ __forceinline__ void xcd_barrier(const XcdBarrier& b) {
    asm volatile("s_waitcnt vmcnt(0)" ::: "memory");
    __syncthreads();
    if (threadIdx.x == 0) {
        unsigned* bar = b.bar;
        __builtin_amdgcn_s_waitcnt(0);
        unsigned nloc = b.st[0], nx = b.st[1];
        if (nloc == 0u) { xcd_barrier_complete(bar, b.x, nloc, nx); b.st[0] = nloc; b.st[1] = nx; }
        const unsigned old = xb_add(&bar[XB_XSUB(b.x)], 1u);
        const unsigned gen = old / nloc;
        if (old + 1u == (gen + 1u) * nloc) {
            __builtin_amdgcn_fence(__ATOMIC_RELEASE, "agent");
            asm volatile("s_waitcnt vmcnt(0)" ::: "memory");
            const unsigned og = xb_add(&bar[XB_TOP], 1u);
            const unsigned tg = og / nx;
            if (og + 1u == (tg + 1u) * nx) xb_add(&bar[XB_TOPGEN], 1u);
            else XB_SPIN(xb_ld(&bar[XB_TOPGEN]) == tg, bar);
            __builtin_amdgcn_fence(__ATOMIC_ACQUIRE, "agent");
            xb_add(&bar[XB_XGEN(b.x)], 1u);
            asm volatile("s_waitcnt vmcnt(0)" ::: "memory");
        } else {
            XB_SPIN(xb_ld(&bar[XB_XGEN(b.x)]) == gen, bar);
            __builtin_amdgcn_fence(__ATOMIC_ACQUIRE, "agent");
            asm volatile("s_waitcnt vmcnt(0)" ::: "memory");
        }
    }
    __syncthreads();
}

__device__ __forceinline__ float wave_sum(float v) {
#pragma unroll
    for (int o = 1; o < 64; o <<= 1) v += __shfl_xor(v, o);
    return v;
}
__device__ __forceinline__ int rope_perm(int p) { return ((p >> 2) & 1) * 16 + 4 * (p >> 3) + (p & 3); }
__device__ __forceinline__ void transpose_block(const float* src, int ld, bf16_t* dst, int Kp, const float* scale, bool rperm, LAS float* scr, int lane) {
    f32x4 r[8];
#pragma unroll
    for (int i = 0; i < 8; ++i) r[i] = *(const f32x4*)(src + (size_t)(8 * i + (lane >> 3)) * ld + (lane & 7) * 4);
#pragma unroll
    for (int i = 0; i < 8; ++i) { const int kk = 8 * i + (lane >> 3); const float sc = scale ? scale[kk] : 1.0f; LAS float* s = scr + kk * 33 + (lane & 7) * 4;
        s[0] = r[i][0] * sc; s[1] = r[i][1] * sc; s[2] = r[i][2] * sc; s[3] = r[i][3] * sc; }
    LDS_WAIT(); asm volatile("" ::: "memory");
    const int c = lane & 7;
#pragma unroll
    for (int j = 0; j < 4; ++j) { const int n = (lane >> 3) + 8 * j; const int ns = rperm ? rope_perm(n) : n; const LAS float* s = scr + (8 * c) * 33 + ns;
        u32x4 o; o.x = cvtpk(s[0 * 33], s[1 * 33]); o.y = cvtpk(s[2 * 33], s[3 * 33]); o.z = cvtpk(s[4 * 33], s[5 * 33]); o.w = cvtpk(s[6 * 33], s[7 * 33]);
        *(u32x4*)(dst + (size_t)n * Kp + 8 * c) = o; }
    LDS_WAIT(); asm volatile("" ::: "memory");
}

#define DPPF(oldv, src, ctrl, rm) __builtin_bit_cast(float, __builtin_amdgcn_update_dpp(__builtin_bit_cast(int, (float)(oldv)), __builtin_bit_cast(int, (float)(src)), ctrl, rm, 0xf, false))
__device__ __forceinline__ float wave_max_u(float x) {
    x = fmaxf(x, DPPF(-INFINITY, x, 0x111, 0xf)); x = fmaxf(x, DPPF(-INFINITY, x, 0x112, 0xf)); x = fmaxf(x, DPPF(-INFINITY, x, 0x114, 0xf)); x = fmaxf(x, DPPF(-INFINITY, x, 0x118, 0xf));
    x = fmaxf(x, DPPF(-INFINITY, x, 0x142, 0xa)); x = fmaxf(x, DPPF(-INFINITY, x, 0x143, 0xc));
    return __builtin_bit_cast(float, __builtin_amdgcn_readlane(__builtin_bit_cast(int, x), 63));
}
struct Args { const float* in[20]; float* out; unsigned char* ws; int ph_lo, ph_hi; };

__device__ __forceinline__ void compute_tileoff(LAS unsigned char* lds, const unsigned* cnt, int tid) {
    LAS int* tl = (LAS int*)(lds + RING_OFF);
    LAS int* to = (LAS int*)(lds + TILEOFF_OFF);
    __syncthreads();
    if (tid < NE1) { const int c = (tid < NEXP) ? (int)__hip_atomic_load(cnt + tid, RLX_AGENT) : TT; tl[tid] = (c + 255) >> 8; }
    __syncthreads();
    if (tid <= NE1) { int s = 0; for (int e = 0; e < tid; ++e) s += tl[e]; to[tid] = s; }
    __syncthreads();
}

__global__ void __launch_bounds__(512, 2) mk_fwd(Args args) {
    extern __shared__ __attribute__((aligned(16))) unsigned char lds_raw[];
    LAS unsigned char* lds = (LAS unsigned char*)lds_raw;
    volatile LAS unsigned* MISC = (volatile LAS unsigned*)(lds + MISC_OFF);
    const int tid = threadIdx.x, lane = tid & 63, wave = __builtin_amdgcn_readfirstlane(tid >> 6);
    const int G = gridDim.x; const int bx = blockIdx.x; const int vcu = (G % 8 == 0) ? (bx % 8) * (G / 8) + bx / 8 : bx;
    unsigned char* ws = args.ws;
    unsigned* ctl = (unsigned*)(ws + WS_CTL);
    const float* x = args.in[0];
#define ROPE ((float*)(ws + WS_ROPE))
#define WinT ((bf16_t*)(ws + WS_WIN))
#define WuqT ((bf16_t*)(ws + WS_WUQ))
#define WukvT ((bf16_t*)(ws + WS_WUKV))
#define WomT ((bf16_t*)(ws + WS_WOM))
#define WosT ((bf16_t*)(ws + WS_WOS))
#define WoutT ((bf16_t*)(ws + WS_WOUT))
#define WrT ((bf16_t*)(ws + WS_WR))
#define WupT ((bf16_t*)(ws + WS_WUP))
#define WdnT ((bf16_t*)(ws + WS_WDN))
#define XB ((bf16_t*)(ws + WS_XB))
#define CQ ((bf16_t*)(ws + WS_CQ))
#define CKV ((bf16_t*)(ws + WS_CKV))
#define QS ((bf16_t*)(ws + WS_QS))
#define KS ((bf16_t*)(ws + WS_KS))
#define VS ((bf16_t*)(ws + WS_VS))
#define GA ((bf16_t*)(ws + WS_GA))
#define GB ((bf16_t*)(ws + WS_GB))
#define QF ((bf16_t*)(ws + WS_QF))
#define KF ((bf16_t*)(ws + WS_KF))
#define VM ((bf16_t*)(ws + WS_VM))
#define AM ((bf16_t*)(ws + WS_AM))
#define AS ((bf16_t*)(ws + WS_AS))
#define MG ((bf16_t*)(ws + WS_MG))
#define H1B ((bf16_t*)(ws + WS_H1B))
#define HID ((bf16_t*)(ws + WS_HID))
#define YS ((unsigned char*)(ws + WS_Y))
#define Y1 ((float*)(ws + WS_Y1))
#define H1F ((float*)(ws + WS_H1F))
#define SC ((float*)(ws + WS_SC))
#define TOPW ((float*)(ws + WS_TOPW))
#define TOPI ((int*)(ws + WS_TOPI))
#define TPOS ((int*)(ws + WS_TPOS))
#define RTOK ((int*)(ws + WS_RTOK))
#define TROW ((int*)(ws + WS_TROW))
#define SSQQ ((float*)(ws + WS_SSQ))
#define SSQKV ((float*)(ws + WS_SSQ) + TT * 4)
#define CNT (ctl + CW_CNT)

    for (int u = tid; u < (LDS_BYTES - LDSCTL_OFF) / 4; u += 512) ((LAS unsigned*)(lds + LDSCTL_OFF))[u] = 0u;
    __syncthreads();
    XcdBarrier bar; bar.bar = ctl + CW_BAR; bar.x = 0; bar.st = nullptr;
    if (MK_N_LAUNCHES == 1) bar = xcd_barrier_post(ctl + CW_BAR, MISC + 8);
    const int lo = args.ph_lo, hi = args.ph_hi;
#define IN(k) (lo <= (k) && (k) < hi)
#define SEAM(k) do { if (IN(k) && IN((k) + 1)) xcd_barrier(bar); if ((PROBE_A >= 0 || PROBE_B >= 0) && bx == 0 && tid == 0) __hip_atomic_store(ctl + CW_TS + (k) + 1, (unsigned)__builtin_amdgcn_s_memrealtime(), RLX_AGENT); } while (0)
    const int gw = vcu * 8 + wave, NGW = G * 8;
    if ((PROBE_A >= 0 || PROBE_B >= 0) && bx == 0 && tid == 0) __hip_atomic_store(ctl + CW_TS, (unsigned)__builtin_amdgcn_s_memrealtime(), RLX_AGENT);

    if (IN(0)) {
        LAS float* scr = (LAS float*)(lds + RING_OFF + wave * 16384);
        constexpr int I_IN = 16 * 105, I_UQ = 4 * 24, I_UKV = 4 * 32, I_OM = 8 * 32, I_OS = 8 * 32, I_OUT = 16 * 32, I_R = 16 * 8, I_UP = NE1 * 256, I_DN = NE1 * 128;
        constexpr int NITEMS = I_IN + I_UQ + I_UKV + I_OM + I_OS + I_OUT + I_R + I_UP + I_DN;
        for (int it = gw; it < NITEMS; it += NGW) {
            int r = it;
            if (r < I_IN) { const int kb = r / 105, sb = r % 105; int db;
                if (sb < 16) db = sb; else if (sb == 16) db = 40; else if (sb < 33) db = sb - 1; else if (sb < 41) db = sb - 1; else db = sb + 7;
                transpose_block(args.in[1] + (size_t)kb * 64 * 3360 + sb * 32, 3360, WinT + (size_t)db * 32 * 1024 + kb * 64, 1024, nullptr, sb == 16, scr, lane); continue; } r -= I_IN;
            if (r < I_UQ) { const int kb = r / 24, nb = r % 24;
                transpose_block(args.in[4] + (size_t)kb * 64 * 768 + nb * 32, 768, WuqT + (size_t)nb * 32 * 256 + kb * 64, 256, args.in[2] + kb * 64, nb % 3 == 2, scr, lane); continue; } r -= I_UQ;
            if (r < I_UKV) { const int kb = r / 32, nb = r % 32;
                transpose_block(args.in[5] + (size_t)kb * 64 * 1024 + nb * 32, 1024, WukvT + (size_t)nb * 32 * 256 + kb * 64, 256, args.in[3] + kb * 64, false, scr, lane); continue; } r -= I_UKV;
            if (r < I_OM) { const int kb = r / 32, nb = r % 32;
                transpose_block(args.in[7] + (size_t)kb * 64 * 1024 + nb * 32, 1024, WomT + (size_t)nb * 32 * 512 + kb * 64, 512, nullptr, false, scr, lane); continue; } r -= I_OM;
            if (r < I_OS) { const int kb = r / 32, nb = r % 32;
                transpose_block(args.in[8] + (size_t)kb * 64 * 1024 + nb * 32, 1024, WosT + (size_t)nb * 32 * 512 + kb * 64, 512, nullptr, false, scr, lane); continue; } r -= I_OS;
            if (r < I_OUT) { const int kb = r / 32, nb = r % 32;
                transpose_block(args.in[9] + (size_t)kb * 64 * 1024 + nb * 32, 1024, WoutT + (size_t)nb * 32 * 1024 + kb * 64, 1024, nullptr, false, scr, lane); continue; } r -= I_OUT;
            if (r < I_R) { const int kb = r / 8, nb = r % 8;
                transpose_block(args.in[12] + (size_t)kb * 64 * 256 + nb * 32, 256, WrT + (size_t)nb * 32 * 1024 + kb * 64, 1024, nullptr, false, scr, lane); continue; } r -= I_R;
            if (r < I_UP) { const int e = r / 256, q = r % 256, kb = q / 16, sb = q % 16;
                const float* W = (e < NEXP) ? args.in[14] + (size_t)e * 1024 * 512 : args.in[16];
                const int db = (sb < 8) ? (sb >> 2) * 8 + (sb & 3) : ((sb - 8) >> 2) * 8 + 4 + ((sb - 8) & 3);
                transpose_block(W + (size_t)kb * 64 * 512 + sb * 32, 512, WupT + (size_t)e * 512 * 1024 + (size_t)db * 32 * 1024 + kb * 64, 1024, nullptr, false, scr, lane); continue; } r -= I_UP;
            { const int e = r / 128, q = r % 128, kb = q / 32, nb = q % 32;
                const float* W = (e < NEXP) ? args.in[15] + (size_t)e * 256 * 1024 : args.in[17];
                transpose_block(W + (size_t)kb * 64 * 1024 + nb * 32, 1024, WdnT + (size_t)e * 1024 * 256 + (size_t)nb * 32 * 256 + kb * 64, 256, nullptr, false, scr, lane); }
        }
        for (size_t i = (size_t)(bx * 512 + tid); i < (size_t)224 * 1024 / 8; i += (size_t)G * 512) *(u32x4*)(WinT + (size_t)1312 * 1024 + i * 8) = (u32x4){0u, 0u, 0u, 0u};
        for (int m = gw; m < TT; m += NGW) { const f32x4* xr = (const f32x4*)(x + (size_t)m * DM) + lane; u32x2* o = (u32x2*)(XB + (size_t)m * DM) + lane;
#pragma unroll
            for (int j = 0; j < 4; ++j) { const f32x4 v = xr[64 * j]; u32x2 w; w.x = cvtpk(v[0], v[1]); w.y = cvtpk(v[2], v[3]); o[64 * j] = w; } }
        for (int i = bx * 512 + tid; i < SEQ * 16; i += G * 512) { const int pos = i >> 4, j = i & 15; const float inv = powf(10000.0f, -(float)(2 * j) / 32.0f); const float ang = (float)pos * inv;
            ROPE[i] = cosf(ang); ROPE[SEQ * 16 + i] = sinf(ang); }
    }
    SEAM(0);
    if (IN(1)) {
        pg8::StaticOrder S; S.init(TT, NIN, G, bx);
        EpiInProj E{CQ, CKV, QS, KS, VS, KF, GA, GB, SSQQ, SSQKV, ROPE};
        pg8::gemm_phase<EpiInProj, pg8::StaticOrder, true, false, (PROBE_G == 1)>(lds + RING_OFF, XB, WinT, 1024, S, E, nullptr, (PROBE_G == 1 && bx == 0) ? ctl + CW_TS + 116 : nullptr);
    }
    SEAM(1);
    if (IN(2)) {
        { pg8::StaticOrder S; S.init(TT, 768, G, bx); EpiQ E{QF, SSQQ, ROPE};
          pg8::gemm_phase<EpiQ, pg8::StaticOrder, true, false, (PROBE_G == 2)>(lds + RING_OFF, CQ, WuqT, 256, S, E, nullptr, (PROBE_G == 2 && bx == 0) ? ctl + CW_TS + 116 : nullptr); }
        { pg8::StaticOrder S; S.init(TT, 1024, G, bx); EpiKV E{KF, VM, SSQKV};
          pg8::gemm_phase<EpiKV, pg8::StaticOrder, true, false, (PROBE_G == 3)>(lds + RING_OFF, CKV, WukvT, 256, S, E, nullptr, (PROBE_G == 3 && bx == 0) ? ctl + CW_TS + 116 : nullptr); }
    }
    SEAM(2);
    if (IN(3)) {
        for (int P = vcu; P < 512; P += G) { const int bh = P >> 2, s = P & 3, b = bh >> 3, h = bh & 7; const size_t rb = (size_t)b * SEQ;
#pragma unroll 1
            for (int z = 0; z < 2; ++z) { const int qb = z ? 7 - s : s;
                attn_unit<96, false>(lds + RING_OFF, QF + rb * 768 + h * 96, 768, KF + rb * 768 + h * 96, 768, VM + rb * 512 + h * 64, 512, AM + rb * 512 + h * 64, 512, qb * 256, 0, 4 * (qb + 1), 0.f, 0.f); } }
        const float* sinks = args.in[6];
#pragma unroll 1
        for (int U = vcu; U < 1024; U += G) { const int bh = U >> 3, qb = U & 7, b = bh >> 3, h = bh & 7, kvh = h >> 2; const size_t rb = (size_t)b * SEQ;
            const float slope2 = exp2f(-(float)(h + 1)) * LOG2E, sink2 = sinks[h] * LOG2E;
            attn_unit<64, true>(lds + RING_OFF, QS + rb * 512 + h * 64, 512, KS + rb * 128 + kvh * 64, 128, VS + rb * 128 + kvh * 64, 128, AS + rb * 512 + h * 64, 512, qb * 256, (4 * qb - 2) < 0 ? 0 : 4 * qb - 2, 4 * qb + 4, slope2, sink2); }
    }
    SEAM(3);
    if (IN(4)) {
        { pg8::StaticOrder S; S.init(TT, 1024, G, bx); EpiGate<false> E{MG, GA};
          pg8::gemm_phase<EpiGate<false>, pg8::StaticOrder, true, false, (PROBE_G == 4)>(lds + RING_OFF, AM, WomT, 512, S, E, nullptr, (PROBE_G == 4 && bx == 0) ? ctl + CW_TS + 116 : nullptr); }
        { pg8::StaticOrder S; S.init(TT, 1024, G, bx); EpiGate<true> E{MG, GB};
          pg8::gemm_phase<EpiGate<true>, pg8::StaticOrder, true, false, (PROBE_G == 5)>(lds + RING_OFF, AS, WosT, 512, S, E, nullptr, (PROBE_G == 5 && bx == 0) ? ctl + CW_TS + 116 : nullptr); }
    }
    SEAM(4);
    if (IN(5)) {
        pg8::StaticOrder S; S.init(TT, 1024, G, bx); EpiOut E{Y1, x};
        pg8::gemm_phase<EpiOut, pg8::StaticOrder, true, false, (PROBE_G == 6)>(lds + RING_OFF, MG, WoutT, 1024, S, E, nullptr, (PROBE_G == 6 && bx == 0) ? ctl + CW_TS + 116 : nullptr);
    }
    SEAM(5);
    if (IN(6)) {
        const float *g1 = args.in[10], *b1 = args.in[11];
        for (int m0 = gw; m0 < TT; m0 += 2 * NGW) {
            f32x4 v[2][4]; const bool two = (m0 + NGW) < TT;
#pragma unroll
            for (int r = 0; r < 2; ++r) { const int m = (r && two) ? m0 + NGW : m0; const f32x4* yr = (const f32x4*)(Y1 + (size_t)m * DM) + lane;
#pragma unroll
                for (int j = 0; j < 4; ++j) v[r][j] = yr[64 * j]; }
#pragma unroll
            for (int r = 0; r < 2; ++r) { if (r && !two) break; const int m = r ? m0 + NGW : m0; float s = 0.f;
#pragma unroll
                for (int j = 0; j < 4; ++j) s += (v[r][j][0] + v[r][j][1]) + (v[r][j][2] + v[r][j][3]);
                const float mean = wave_sum(s) * (1.f / DM); float s2 = 0.f;
#pragma unroll
                for (int j = 0; j < 4; ++j) { v[r][j] = v[r][j] - mean; s2 += (v[r][j][0] * v[r][j][0] + v[r][j][1] * v[r][j][1]) + (v[r][j][2] * v[r][j][2] + v[r][j][3] * v[r][j][3]); }
                const float rstd = 1.f / sqrtf(wave_sum(s2) * (1.f / DM) + LN_EPS);
                f32x4* of = (f32x4*)(H1F + (size_t)m * DM) + lane; u32x2* ob = (u32x2*)(H1B + (size_t)m * DM) + lane;
#pragma unroll
                for (int j = 0; j < 4; ++j) { const f32x4 gg = ((const f32x4*)g1)[lane + 64 * j], bb = ((const f32x4*)b1)[lane + 64 * j]; const f32x4 o = v[r][j] * rstd * gg + bb;
                    of[64 * j] = o; u32x2 w; w.x = cvtpk(o[0], o[1]); w.y = cvtpk(o[2], o[3]); ob[64 * j] = w; } }
        }
    }
    SEAM(6);
    if (IN(7)) {
        pg8::StaticOrder S; S.init(TT, 256, G, bx); EpiRouter E{SC};
        pg8::gemm_phase<EpiRouter, pg8::StaticOrder, true, false, (PROBE_G == 7)>(lds + RING_OFF, H1B, WrT, 1024, S, E, nullptr, (PROBE_G == 7 && bx == 0) ? ctl + CW_TS + 116 : nullptr);
    }
    SEAM(7);
    if (IN(8)) {
        const float* rbias = args.in[13];
        LAS int* hist = (LAS int*)(lds + RING_OFF); LAS int* base = hist + 256; LAS int* te = hist + 512; LAS float* tw = (LAS float*)(hist + 1536); LAS int* tlp = hist + 2560;
        for (int i = bx * 512 + tid; i < MAXROWS; i += G * 512) RTOK[i] = 0;
        const f32x4 b4 = *(const f32x4*)(rbias + 4 * lane);
        for (int chunk = vcu; chunk < TT / 128; chunk += G) {
            __syncthreads();
            if (tid < 256) hist[tid] = 0;
            __syncthreads();
#pragma unroll 1
            for (int j0 = 0; j0 < 16; j0 += 4) { const int tl0 = wave * 16 + j0, t0 = chunk * 128 + tl0;
                float c[4][4]; int myidx[4]; float gs[4]; int rank[4];
#pragma unroll
                for (int u = 0; u < 4; ++u) { const f32x4 s4 = *(const f32x4*)(SC + (size_t)(t0 + u) * 256 + 4 * lane);
                    c[u][0] = s4[0] + b4[0]; c[u][1] = s4[1] + b4[1]; c[u][2] = s4[2] + b4[2]; c[u][3] = s4[3] + b4[3]; }
                { float m1[4], m2[4];
#pragma unroll
                  for (int u = 0; u < 4; ++u) { const float a = fmaxf(c[u][0], c[u][1]), b = fminf(c[u][0], c[u][1]), d = fmaxf(c[u][2], c[u][3]), e = fminf(c[u][2], c[u][3]); m1[u] = fmaxf(a, d); m2[u] = fmaxf(fminf(a, d), fmaxf(b, e)); }
#define MERGE2(ctrl) _Pragma("unroll") for (int u = 0; u < 4; ++u) { const float o1 = DPPF(m1[u], m1[u], ctrl, 0xf), o2 = DPPF(m2[u], m2[u], ctrl, 0xf); const float n1 = fmaxf(m1[u], o1), n2 = fmaxf(fminf(m1[u], o1), fmaxf(m2[u], o2)); m1[u] = n1; m2[u] = n2; }
                  MERGE2(0xB1) MERGE2(0x4E) MERGE2(0x141)
#undef MERGE2
#pragma unroll
                  for (int u = 0; u < 4; ++u) { gs[u] = m1[u] + m2[u]; rank[u] = 0; } }
                { const int g = lane >> 3;
#pragma unroll
                  for (int gg = 0; gg < 8; ++gg) {
#pragma unroll
                      for (int u = 0; u < 4; ++u) { const float og = __builtin_bit_cast(float, __builtin_amdgcn_readlane(__builtin_bit_cast(int, gs[u]), gg * 8)); rank[u] += (og > gs[u] || (og == gs[u] && gg < g)) ? 1 : 0; } } }
#pragma unroll
                for (int u = 0; u < 4; ++u) { if (rank[u] >= 4) { c[u][0] = -INFINITY; c[u][1] = -INFINITY; c[u][2] = -INFINITY; c[u][3] = -INFINITY; } myidx[u] = 0; }
#pragma unroll 1
                for (int k = 0; k < 8; ++k) {
#pragma unroll
                    for (int u = 0; u < 4; ++u) {
                        const float wm = wave_max_u(fmaxf(fmaxf(c[u][0], c[u][1]), fmaxf(c[u][2], c[u][3])));
                        int widx = 1 << 20;
#pragma unroll
                        for (int q = 0; q < 4; ++q) { const unsigned long long bq = __ballot(c[u][q] == wm); const int cand = bq ? 4 * (int)__builtin_ctzll(bq) + q : (1 << 20); widx = cand < widx ? cand : widx; }
#pragma unroll
                        for (int q = 0; q < 4; ++q) c[u][q] = (4 * lane + q == widx) ? -INFINITY : c[u][q];
                        if (lane == k) myidx[u] = widx; }
                }
#pragma unroll
                for (int u = 0; u < 4; ++u) { const int tl = tl0 + u;
                    float sw = (lane < 8) ? SC[(size_t)(t0 + u) * 256 + myidx[u]] : 0.f;
                    float ssum = sw; ssum += DPPF(0.f, ssum, 0xB1, 0xf); ssum += DPPF(0.f, ssum, 0x4E, 0xf); ssum += DPPF(0.f, ssum, 0x141, 0xf);
                    if (lane < 8) { const int lp = __hip_atomic_fetch_add(hist + myidx[u], 1, __ATOMIC_RELAXED, __HIP_MEMORY_SCOPE_WORKGROUP);
                        te[tl * 8 + lane] = myidx[u]; tw[tl * 8 + lane] = sw / ssum * 2.5f; tlp[tl * 8 + lane] = lp; } }
            }
            __syncthreads();
            if (tid < 256) { const int hc = hist[tid]; base[tid] = hc ? (int)__hip_atomic_fetch_add(CNT + tid, (unsigned)hc, RLX_AGENT) : 0; }
            __syncthreads();
            for (int p = tid; p < 1024; p += 512) { const int e = te[p]; const size_t o = (size_t)(chunk * 128) * 8 + p; TOPI[o] = e; TOPW[o] = tw[p]; TPOS[o] = base[e] + tlp[p]; }
        }
    }
    SEAM(8);
    if (IN(9)) {
        compute_tileoff(lds, CNT, tid);
        const LAS int* to = (const LAS int*)(lds + TILEOFF_OFF);
        for (int p = bx * 512 + tid; p < TT * 8; p += G * 512) { const int e = TOPI[p]; const int row = to[e] * 256 + TPOS[p]; const int t = p >> 3;
            RTOK[row] = t; TROW[t * 9 + (p & 7)] = row; }
        const int sh0 = to[NEXP] * 256;
        for (int t = bx * 512 + tid; t < TT; t += G * 512) { RTOK[sh0 + t] = t; TROW[t * 9 + 8] = sh0 + t; }
    }
    SEAM(9);
    if (IN(10)) {
        compute_tileoff(lds, CNT, tid);
        const LAS int* to = (const LAS int*)(lds + TILEOFF_OFF);
        LAS int* rowtab = (LAS int*)(lds + ROWTAB_OFF);
        pg8::GroupOrder S; S.init(to[NE1], 2, G, bx, to);
        for (int i = 0; i < ROWTAB_UNITS; ++i) { pg8::Unit u; if (!S.next(i, u)) break; if (tid < 256) rowtab[i * 256 + tid] = RTOK[u.pm * 256 + tid]; }
        __syncthreads();
        EpiUp E{HID};
        pg8::gemm_phase<EpiUp, pg8::GroupOrder, true, true, (PROBE_G == 10)>(lds + RING_OFF, H1B, WupT, 1024, S, E, rowtab, (PROBE_G == 10 && bx == 0) ? ctl + CW_TS + 116 : nullptr);
    }
    SEAM(10);
    if (IN(11)) {
        compute_tileoff(lds, CNT, tid);
        const LAS int* to = (const LAS int*)(lds + TILEOFF_OFF);
        pg8::GroupOrder S; S.init(to[NE1], 4, G, bx, to);
        EpiDown E{YS};
        pg8::gemm_phase<EpiDown, pg8::GroupOrder, true, false, (PROBE_G == 11)>(lds + RING_OFF, HID, WdnT, 256, S, E, nullptr, (PROBE_G == 11 && bx == 0) ? ctl + CW_TS + 116 : nullptr);
    }
    SEAM(11);
    if (IN(12)) {
        const float *g2 = args.in[18], *b2 = args.in[19];
        for (int m = gw; m < TT; m += NGW) {
            f32x4 v[4];
            { const float* hr = H1F + (size_t)m * DM + 16 * lane;
#pragma unroll
              for (int q = 0; q < 4; ++q) v[q] = *(const f32x4*)(hr + 4 * q) * ALPHA; }
            const int myrow = (lane < 9) ? TROW[m * 9 + lane] : 0; const float myw = (lane < 8) ? TOPW[m * 8 + lane] : 1.0f;
#pragma unroll
            for (int k = 0; k < 9; ++k) { const int r = __builtin_amdgcn_readlane(myrow, k); const float w = __builtin_bit_cast(float, __builtin_amdgcn_readlane(__builtin_bit_cast(int, myw), k));
                const u32x4 y = *(const u32x4*)(YS + (size_t)r * 1024 + 16 * lane);
#pragma unroll
                for (int q = 0; q < 4; ++q) { const f32x2 lo = __builtin_amdgcn_cvt_pk_f32_fp8(y[q], false), hi2 = __builtin_amdgcn_cvt_pk_f32_fp8(y[q], true);
                    v[q][0] += w * lo[0]; v[q][1] += w * lo[1]; v[q][2] += w * hi2[0]; v[q][3] += w * hi2[1]; } }
            float s = 0.f;
#pragma unroll
            for (int q = 0; q < 4; ++q) s += (v[q][0] + v[q][1]) + (v[q][2] + v[q][3]);
            const float mean = wave_sum(s) * (1.f / DM); float s2 = 0.f;
#pragma unroll
            for (int q = 0; q < 4; ++q) { v[q] = v[q] - mean; s2 += (v[q][0] * v[q][0] + v[q][1] * v[q][1]) + (v[q][2] * v[q][2] + v[q][3] * v[q][3]); }
            const float rstd = 1.f / sqrtf(wave_sum(s2) * (1.f / DM) + LN_EPS);
#pragma unroll
            for (int q = 0; q < 4; ++q) { const int c = 16 * lane + 4 * q; const f32x4 gg = *(const f32x4*)(g2 + c), bb = *(const f32x4*)(b2 + c);
                    f32x4 ov = v[q] * rstd * gg + bb;
                    if (PROBE_A >= 0) { const float du = (PROBE_A >= 100 ? (float)__hip_atomic_load(ctl + CW_TS + 16 + PROBE_A, RLX_AGENT) : (float)(__hip_atomic_load(ctl + CW_TS + PROBE_A + 1, RLX_AGENT) - __hip_atomic_load(ctl + CW_TS + PROBE_A, RLX_AGENT))) * 0.01f; const float eps = sqrtf(du * 1e-5f);
                        for (int z = 0; z < 4; ++z) { unsigned hsh = (unsigned)(m * 1024 + c + z) * 2654435761u; hsh ^= hsh >> 15; hsh *= 2246822519u; hsh ^= hsh >> 13; ov[z] += (hsh & 4096u) ? eps : -eps; } }
                    if (PROBE_B >= 0 && m == 0 && c == 0) { const float du = (PROBE_B >= 100 ? (float)__hip_atomic_load(ctl + CW_TS + 16 + PROBE_B, RLX_AGENT) : (float)(__hip_atomic_load(ctl + CW_TS + PROBE_B + 1, RLX_AGENT) - __hip_atomic_load(ctl + CW_TS + PROBE_B, RLX_AGENT))) * 0.01f; ov[0] += du * 0.1f; }
                    *(f32x4*)(args.out + (size_t)m * DM + c) = ov; }
        }
    }
#undef IN
#undef SEAM
}

extern "C" void kernel_launch(void* const* d_in, const int* in_sizes, int n_in, void* d_out, int out_size, void* d_ws, size_t ws_size, hipStream_t stream) {
    static int grid = 0;
    if (grid == 0) {
        if (n_in != 20 || in_sizes[0] != TT * DM || out_size != TT * DM || ws_size < WS_END) { fprintf(stderr, "kernel_launch: unexpected shapes / workspace (%d inputs, ws %zu < %zu)\n", n_in, ws_size, (size_t)WS_END); grid = -1; return; }
        int dev = 0, cus = 0, per_cu = 0;
        if (hipGetDevice(&dev) != hipSuccess || hipDeviceGetAttribute(&cus, hipDeviceAttributeMultiprocessorCount, dev) != hipSuccess) { grid = -1; return; }
        if (hipFuncSetAttribute((const void*)mk_fwd, hipFuncAttributeMaxDynamicSharedMemorySize, LDS_BYTES) != hipSuccess) { fprintf(stderr, "kernel_launch: hipFuncSetAttribute failed\n"); grid = -1; return; }
        if (hipOccupancyMaxActiveBlocksPerMultiprocessor(&per_cu, (const void*)mk_fwd, 512, LDS_BYTES) != hipSuccess || per_cu < 1) { fprintf(stderr, "kernel_launch: occupancy query says %d\n", per_cu); per_cu = 1; }
        (void)hipGetLastError();
        grid = cus;
    }
    if (grid < 0) return;
    (void)hipMemsetAsync((char*)d_ws + WS_CTL, 0, CTL_ZERO_BYTES, stream);
    Args a{};
    for (int i = 0; i < 20; ++i) a.in[i] = (const float*)d_in[i];
    a.out = (float*)d_out; a.ws = (unsigned char*)d_ws;
    if (MK_N_LAUNCHES == 1) { a.ph_lo = 0; a.ph_hi = 13; hipLaunchKernelGGL(mk_fwd, dim3(grid), dim3(512), LDS_BYTES, stream, a); }
    else for (int p = 0; p < 13; ++p) { a.ph_lo = p; a.ph_hi = p + 1; hipLaunchKernelGGL(mk_fwd, dim3(grid), dim3(512), LDS_BYTES, stream, a); }
}
```
